# Optimizing an MI355X kernel written in HIP

```python
import jax, jax.numpy as jnp
from jax import lax
import numpy as np

D_MODEL = 1024
BATCH = 2
SEQ = 8192
DEPTH = 1

N_MEM = 256
HEAD_DIM = 128
HEADS_PER_GROUP = 4
DIL_GROUPS = ((128, 1), (512, 4), (2048, 16))
N_GROUPS = len(DIL_GROUPS)
ATTN_HEADS = N_GROUPS * HEADS_PER_GROUP
ATTN_WIDTH = ATTN_HEADS * HEAD_DIM
ATTN_OUT = HEADS_PER_GROUP * HEAD_DIM
ROT_DIM = HEAD_DIM // 4
ROPE_THETA = 500000.0
CONV_CH = 3 * D_MODEL // 4
CONV_K = 31
N_BRANCH = 2
IN_SPLITS = (ATTN_WIDTH, ATTN_WIDTH, ATTN_WIDTH, CONV_CH, CONV_CH, D_MODEL, D_MODEL)
IN_WIDTH = sum(IN_SPLITS)
CROSS_HEADS = 4
CROSS_HEAD_DIM = D_MODEL // CROSS_HEADS
D_FF = 4 * D_MODEL
EPS = 1e-6

kernel_name = 'hybrid_dilated_attn_conformer_conv_gated'


def rmsnorm(x, g):
    xf = x.astype(jnp.float32)
    y = xf * lax.rsqrt(jnp.mean(xf * xf, axis=-1, keepdims=True) + EPS) * g.astype(jnp.float32)
    return y.astype(x.dtype)


def layernorm(x, g, b):
    xf = x.astype(jnp.float32)
    mu = jnp.mean(xf, axis=-1, keepdims=True)
    var = jnp.mean(jnp.square(xf - mu), axis=-1, keepdims=True)
    y = (xf - mu) * lax.rsqrt(var + EPS) * g.astype(jnp.float32) + b.astype(jnp.float32)
    return y.astype(x.dtype)


def rope_partial(t, pos):
    half = ROT_DIM // 2
    inv_freq = ROPE_THETA ** (-jnp.arange(0, ROT_DIM, 2, dtype=jnp.float32) / ROT_DIM)
    ang = pos[:, None] * inv_freq[None, :]
    cos = jnp.cos(ang)[None, :, None, :]
    sin = jnp.sin(ang)[None, :, None, :]
    tf = t.astype(jnp.float32)
    x1, x2, rest = tf[..., :half], tf[..., half:ROT_DIM], tf[..., ROT_DIM:]
    out = jnp.concatenate([x1 * cos - x2 * sin, x2 * cos + x1 * sin, rest], axis=-1)
    return out.astype(t.dtype)


def dilated_window_attention(q, k, v, window, dilation):
    B, S, H, Dh = q.shape
    L = window // dilation
    span = dilation * L
    Sp = -(-S // span) * span
    M = Sp // dilation
    nb = M // L
    pad = ((0, 0), (0, Sp - S), (0, 0), (0, 0))

    def to_blocks(t):
        t = jnp.pad(t, pad).reshape(B, M, dilation, H, Dh)
        t = t.transpose(0, 3, 2, 1, 4)
        return t.reshape(B, H, dilation, nb, L, Dh)

    def with_prev(t):
        prev = jnp.pad(t, ((0, 0), (0, 0), (0, 0), (1, 0), (0, 0), (0, 0)))[:, :, :, :-1]
        return jnp.concatenate([prev, t], axis=-2)

    qb = to_blocks(q)
    kw = with_prev(to_blocks(k))
    vw = with_prev(to_blocks(v))
    s = jnp.einsum('bhrnqe,bhrnke->bhrnqk', qb, kw).astype(jnp.float32) * (Dh ** -0.5)
    qi = jnp.arange(L)[:, None]
    kj = jnp.arange(2 * L)[None, :]
    band = (kj >= qi) & (kj <= qi + L)
    first = (jnp.arange(nb)[:, None, None] == 0) & (kj[None] < L)
    mask = band[None] & jnp.logical_not(first)
    s = jnp.where(mask, s, -jnp.inf)
    lse = jax.nn.logsumexp(s, axis=-1)
    p = jnp.exp(s - lse[..., None])
    o = jnp.einsum('bhrnqk,bhrnke->bhrnqe', p.astype(v.dtype), vw)
    o = o.reshape(B, H, dilation, M, Dh).transpose(0, 3, 2, 1, 4).reshape(B, Sp, H, Dh)[:, :S]
    lse = lse.reshape(B, H, dilation, M).transpose(0, 3, 2, 1).reshape(B, Sp, H)[:, :S]
    return o, lse


def setup_inputs(seed: int = 0) -> dict:
    key = jax.random.key(seed)
    ks = jax.random.split(key, 24)
    f32 = jnp.float32
    nrm = lambda k, shape, fan: jax.random.normal(k, shape, f32) * (fan ** -0.5)
    gain = lambda k, shape: 1.0 + 0.01 * jax.random.normal(k, shape, f32)
    small = lambda k, shape: 0.01 * jax.random.normal(k, shape, f32)
    return {
        'x': jax.random.normal(ks[0], (BATCH, SEQ, D_MODEL), f32),
        'mem': jax.random.normal(ks[1], (BATCH, N_MEM, D_MODEL), f32),
        'g_mix': gain(ks[2], (DEPTH, D_MODEL)),
        'w_in': nrm(ks[3], (DEPTH, D_MODEL, IN_WIDTH), D_MODEL),
        'b_gate': small(ks[4], (DEPTH, N_BRANCH * D_MODEL)),
        'conv_w': nrm(ks[5], (DEPTH, CONV_K, CONV_CH), CONV_K),
        'conv_b': small(ks[6], (DEPTH, CONV_CH)),
        'conv_ln_g': gain(ks[7], (DEPTH, CONV_CH)),
        'conv_ln_b': small(ks[8], (DEPTH, CONV_CH)),
        'w_attn_proj': nrm(ks[9], (DEPTH, ATTN_OUT, D_MODEL), ATTN_OUT),
        'w_conv_proj': nrm(ks[10], (DEPTH, CONV_CH, D_MODEL), CONV_CH),
        'w_out': nrm(ks[11], (DEPTH, D_MODEL, D_MODEL), D_MODEL),
        'g_cross': gain(ks[12], (DEPTH, D_MODEL)),
        'g_mem': gain(ks[13], (DEPTH, D_MODEL)),
        'w_cq': nrm(ks[14], (DEPTH, D_MODEL, D_MODEL), D_MODEL),
        'w_ckv': nrm(ks[15], (DEPTH, D_MODEL, 2 * D_MODEL), D_MODEL),
        'w_co': nrm(ks[16], (DEPTH, D_MODEL, D_MODEL), D_MODEL),
        'g_mlp': gain(ks[17], (DEPTH, D_MODEL)),
        'w_up': nrm(ks[18], (DEPTH, D_MODEL, D_FF), D_MODEL),
        'w_down': nrm(ks[19], (DEPTH, D_FF, D_MODEL), D_FF),
        'g_final': gain(ks[20], (D_MODEL,)),
    }


def reference(x, mem, g_mix, w_in, b_gate, conv_w, conv_b, conv_ln_g, conv_ln_b, w_attn_proj,
              w_conv_proj, w_out, g_cross, g_mem, w_cq, w_ckv, w_co, g_mlp, w_up, w_down, g_final):
    B, S, _ = x.shape
    pos = jnp.arange(S, dtype=jnp.float32)
    split_pts = [int(v) for v in np.cumsum(IN_SPLITS)[:-1]]
    for l in range(DEPTH):
        u = rmsnorm(x, g_mix[l])
        z = u @ w_in[l]
        q, k, v, glu_a, glu_b, gate_a, gate_b = jnp.split(z, split_pts, axis=-1)
        q = rope_partial(q.reshape(B, S, ATTN_HEADS, HEAD_DIM), pos)
        k = rope_partial(k.reshape(B, S, ATTN_HEADS, HEAD_DIM), pos)
        v = v.reshape(B, S, ATTN_HEADS, HEAD_DIM)
        q = q.reshape(B, S, N_GROUPS, HEADS_PER_GROUP, HEAD_DIM)
        k = k.reshape(B, S, N_GROUPS, HEADS_PER_GROUP, HEAD_DIM)
        v = v.reshape(B, S, N_GROUPS, HEADS_PER_GROUP, HEAD_DIM)
        outs, lses = [], []
        for g, (win, dil) in enumerate(DIL_GROUPS):
            o_g, lse_g = dilated_window_attention(q[:, :, g], k[:, :, g], v[:, :, g], win, dil)
            outs.append(o_g)
            lses.append(lse_g)
        wts = jax.nn.softmax(jnp.stack(lses, axis=0), axis=0)
        attn = jnp.sum(wts[..., None] * jnp.stack(outs, axis=0).astype(jnp.float32), axis=0)
        y_attn = attn.astype(x.dtype).reshape(B, S, ATTN_OUT) @ w_attn_proj[l]

        c = glu_a * jax.nn.sigmoid(glu_b)
        c = lax.conv_general_dilated(c, conv_w[l].astype(c.dtype)[:, None, :], window_strides=(1,),
                                     padding=[(CONV_K - 1, 0)], dimension_numbers=('NWC', 'WIO', 'NWC'),
                                     feature_group_count=CONV_CH) + conv_b[l]
        c = jax.nn.silu(layernorm(c, conv_ln_g[l], conv_ln_b[l]))
        y_conv = c @ w_conv_proj[l]

        bg_a, bg_b = jnp.split(b_gate[l], 2)
        merged = jax.nn.sigmoid(gate_a + bg_a) * y_attn + jax.nn.sigmoid(gate_b + bg_b) * y_conv
        x = x + merged @ w_out[l]

        uq = rmsnorm(x, g_cross[l])
        m = rmsnorm(mem, g_mem[l])
        cq = (uq @ w_cq[l]).reshape(B, S, CROSS_HEADS, CROSS_HEAD_DIM)
        ck, cv = jnp.split(m @ w_ckv[l], 2, axis=-1)
        ck = ck.reshape(B, N_MEM, CROSS_HEADS, CROSS_HEAD_DIM)
        cv = cv.reshape(B, N_MEM, CROSS_HEADS, CROSS_HEAD_DIM)
        sc = jnp.einsum('bshe,bmhe->bhsm', cq, ck).astype(jnp.float32) * (CROSS_HEAD_DIM ** -0.5)
        pc = jax.nn.softmax(sc, axis=-1).astype(cv.dtype)
        co = jnp.einsum('bhsm,bmhe->bshe', pc, cv).reshape(B, S, D_MODEL)
        x = x + co @ w_co[l]

        h = jnp.square(jax.nn.relu(rmsnorm(x, g_mlp[l]) @ w_up[l]))
        x = x + h @ w_down[l]
    return rmsnorm(x, g_final)
```

```cpp
#include <hip/hip_runtime.h>
#include <cstdio>
#include <cstdint>
namespace pg8 {
#define PG8_LAS __attribute__((address_space(3)))
typedef unsigned short bf16_t;
typedef short bf16x8 __attribute__((ext_vector_type(8)));
typedef float f32x4 __attribute__((ext_vector_type(4)));
typedef unsigned u32x4 __attribute__((ext_vector_type(4)));
constexpr int BM = 256, BK = 64, HALF = 128, HTB = HALF * BK * 2  , STAGE_BYTES = 8 * HTB, NXCD = 8, WGM = 8;

__host__ __device__ __forceinline__ int lds_byte(int r, int c) { const int st = (r >> 4) * 2 + (c >> 5), rr = r & 15, cc = c & 31, ob = rr * 64 + cc * 2; return st * 1024 + (ob ^ (((ob >> 9) & 1) << 5)); }
__host__ __device__ __forceinline__ void stage_rc(int b, int& R, int& C) { const int st = b / 1024, sb = b % 1024, swz = sb ^ (((sb >> 9) & 1) << 5); R = (st >> 1) * 16 + swz / 64; C = (st & 1) * 32 + (swz % 64) / 2; }
__host__ __device__ __forceinline__ int perm32(int rho) { const int n = rho >> 4, i = rho & 15; return 8 * (i >> 2) + 4 * n + (i & 3); }

struct Unit { int pm, pn; };
struct Gemm { const bf16_t* A; const bf16_t* Bt; int M, N, K; };

struct StaticOrder {
    int nM, nN, nwg, G, c;
    __host__ __device__ void init(int M, int N, int G_, int c_) { nM = M / BM; nN = N / BM; nwg = nM * nN; G = G_; c = c_; }
    __host__ __device__ bool next(int i, Unit& u) const {
        const long L = (long)i * G + c; if (L >= nwg) return false;
        int wgid = (int)L; { const int q = nwg / NXCD, r = nwg % NXCD, xcd = wgid % NXCD, off = wgid / NXCD; wgid = (xcd < r ? xcd * (q + 1) : r * (q + 1) + (xcd - r) * q) + off; }
        const int nig = WGM * nN, gid = wgid / nig, fm = gid * WGM, gsz = (nM - fm) < WGM ? (nM - fm) : WGM;
        u.pm = fm + ((wgid % nig) % gsz); u.pn = (wgid % nig) / gsz; return true;
    }
    __device__ __forceinline__ void a_ready(const Unit&) const {}
    __device__ __forceinline__ void done(const Unit&) const {}
};

typedef float f32x2 __attribute__((ext_vector_type(2)));
typedef __bf16 bf16x2_t __attribute__((ext_vector_type(2)));
__device__ __forceinline__ unsigned cvt_pk_bf16(float lo, float hi) { const f32x2 v = {lo, hi}; const bf16x2_t b = __builtin_convertvector(v, bf16x2_t); return __builtin_bit_cast(unsigned, b); }
typedef float f32x2 __attribute__((ext_vector_type(2)));
typedef unsigned u32x2 __attribute__((ext_vector_type(2)));
__device__ __forceinline__ float sigmoidf_fast(float x) { return __builtin_amdgcn_rcpf(1.0f + __builtin_amdgcn_exp2f(-1.4426950408889634f * x)); }
__device__ __forceinline__ u32x4 pack8(const f32x4 v0, const f32x4 v1) { u32x4 w; w.x = cvt_pk_bf16(v0[0], v0[1]); w.y = cvt_pk_bf16(v0[2], v0[3]); w.z = cvt_pk_bf16(v1[0], v1[1]); w.w = cvt_pk_bf16(v1[2], v1[3]); return w; }
__device__ __forceinline__ f32x4 bf4_to_f32(const u32x2 w) { f32x4 r; r[0] = __uint_as_float(w.x << 16); r[1] = __uint_as_float(w.x & 0xffff0000u); r[2] = __uint_as_float(w.y << 16); r[3] = __uint_as_float(w.y & 0xffff0000u); return r; }

struct EpiPlainBf16 {
    static constexpr bool PERM = true, AFTER_DRAIN = false;
    bf16_t* O; int ldc;
    __device__ __forceinline__ void operator()(const f32x4 (&acc)[2][2][4][2], const Unit& u, int wr, int wc, int fr, int fq) const {
        const int row0 = u.pm * BM + wr * 64 + fr, col0 = u.pn * BM + wc * 32 + 8 * fq;
#pragma unroll
        for (int ai = 0; ai < 2; ++ai)
#pragma unroll
            for (int m = 0; m < 4; ++m) { bf16_t* rowp = O + (size_t)(row0 + ai * HALF + m * 16) * ldc + col0;
#pragma unroll
                for (int bj = 0; bj < 2; ++bj) *(u32x4*)(rowp + bj * HALF) = pack8(acc[ai][bj][m][0], acc[ai][bj][m][1]); }
    }
};

struct EpiG1 {
    static constexpr bool PERM = true, AFTER_DRAIN = false;
    bf16_t* Z; bf16_t* C; bf16_t* G; const float* cs; const float* bgate; float qscale;
    __device__ __forceinline__ void operator()(const f32x4 (&acc)[2][2][4][2], const Unit& u, int wr, int wc, int fr, int fq) const {
        const int row0 = u.pm * BM + wr * 64 + fr; const int pn = u.pn;
        if (pn < 18) {
            const bool rope = (pn < 12) && (wc == 0);
            const float sc = pn < 6 ? qscale : 1.f;
            const int col0 = pn * BM + wc * 32 + 8 * fq;
#pragma unroll
            for (int ai = 0; ai < 2; ++ai)
#pragma unroll
                for (int m = 0; m < 4; ++m) { const int row = row0 + ai * HALF + m * 16; bf16_t* rowp = Z + (size_t)row * 4608 + col0;
                    f32x4 cA = {1.f, 1.f, 1.f, 1.f}, sA = {0.f, 0.f, 0.f, 0.f};
                    if (rope) { const float* t = cs + ((size_t)(row & 8191) * 16 + 4 * fq) * 2; const f32x4 t0 = *(const f32x4*)t, t1 = *(const f32x4*)(t + 4);
                        cA = (f32x4){t0[0], t0[2], t1[0], t1[2]}; sA = (f32x4){t0[1], t0[3], t1[1], t1[3]}; }
#pragma unroll
                    for (int bj = 0; bj < 2; ++bj) { const f32x4 x1 = acc[ai][bj][m][0], x2 = acc[ai][bj][m][1];
                        const f32x4 o1 = (x1 * cA - x2 * sA) * sc, o2 = (x2 * cA + x1 * sA) * sc;
                        *(u32x4*)(rowp + bj * HALF) = pack8(o1, o2); } }
        } else if (pn < 24) {
            const int ch0 = (pn - 18) * HALF + wc * 32 + 8 * fq;
#pragma unroll
            for (int ai = 0; ai < 2; ++ai)
#pragma unroll
                for (int m = 0; m < 4; ++m) { const int row = row0 + ai * HALF + m * 16; f32x4 o[2];
#pragma unroll
                    for (int n = 0; n < 2; ++n) { const f32x4 a = acc[ai][0][m][n], b = acc[ai][1][m][n];
#pragma unroll
                        for (int j = 0; j < 4; ++j) o[n][j] = a[j] * sigmoidf_fast(b[j]); }
                    *(u32x4*)(C + (size_t)row * 768 + ch0) = pack8(o[0], o[1]); }
        } else {
            const int g0 = (pn - 24) * BM + wc * 32 + 8 * fq;
            f32x4 bv[2][2];
#pragma unroll
            for (int bj = 0; bj < 2; ++bj)
#pragma unroll
                for (int n = 0; n < 2; ++n) bv[bj][n] = *(const f32x4*)(bgate + g0 + bj * HALF + 4 * n);
#pragma unroll
            for (int ai = 0; ai < 2; ++ai)
#pragma unroll
                for (int m = 0; m < 4; ++m) { const int row = row0 + ai * HALF + m * 16; bf16_t* rowp = G + (size_t)row * 2048 + g0;
#pragma unroll
                    for (int bj = 0; bj < 2; ++bj) { f32x4 o[2];
#pragma unroll
                        for (int n = 0; n < 2; ++n) { const f32x4 v = acc[ai][bj][m][n] + bv[bj][n];
#pragma unroll
                            for (int j = 0; j < 4; ++j) o[n][j] = sigmoidf_fast(v[j]); }
                        *(u32x4*)(rowp + bj * HALF) = pack8(o[0], o[1]); } }
        }
    }
};

template <int PASS> struct EpiGate {
    static constexpr bool PERM = true, AFTER_DRAIN = false;
    const bf16_t* G; int goff; float* tmp; bf16_t* O;
    __device__ __forceinline__ void operator()(const f32x4 (&acc)[2][2][4][2], const Unit& u, int wr, int wc, int fr, int fq) const {
        const int row0 = u.pm * BM + wr * 64 + fr, col0 = u.pn * BM + wc * 32 + 8 * fq;
#pragma unroll
        for (int ai = 0; ai < 2; ++ai)
#pragma unroll
            for (int m = 0; m < 4; ++m) { const int row = row0 + ai * HALF + m * 16;
#pragma unroll
                for (int bj = 0; bj < 2; ++bj) { const int col = col0 + bj * HALF;
                    const u32x4 gw = *(const u32x4*)(G + (size_t)row * 2048 + goff + col);
                    const f32x4 g0 = bf4_to_f32((u32x2){gw.x, gw.y}), g1 = bf4_to_f32((u32x2){gw.z, gw.w});
                    float* tp = tmp + (size_t)row * 1024 + col;
                    if (PASS == 0) { *(f32x4*)tp = g0 * acc[ai][bj][m][0]; *(f32x4*)(tp + 4) = g1 * acc[ai][bj][m][1]; }
                    else { const f32x4 o0 = *(const f32x4*)tp + g0 * acc[ai][bj][m][0], o1 = *(const f32x4*)(tp + 4) + g1 * acc[ai][bj][m][1];
                        *(u32x4*)(O + (size_t)row * 1024 + col) = pack8(o0, o1); } } }
    }
};

struct EpiRes {
    static constexpr bool PERM = false, AFTER_DRAIN = false;
    const float* base; float* out; bf16_t* xb; float* ssq;
    __device__ __forceinline__ void operator()(const f32x4 (&acc)[2][2][4][2], const Unit& u, int wr, int wc, int fr, int fq) const {
        const int row0 = u.pm * BM + wr * 64 + fr, col0 = u.pn * BM + wc * 32 + 4 * fq;
#pragma unroll
        for (int ai = 0; ai < 2; ++ai)
#pragma unroll
            for (int m = 0; m < 4; ++m) { const int row = row0 + ai * HALF + m * 16; const size_t off = (size_t)row * 1024 + col0; float sq = 0.f;
#pragma unroll
                for (int bj = 0; bj < 2; ++bj)
#pragma unroll
                    for (int n = 0; n < 2; ++n) { const f32x4 o = *(const f32x4*)(base + off + bj * HALF + n * 16) + acc[ai][bj][m][n];
                        *(f32x4*)(out + off + bj * HALF + n * 16) = o; sq += (o[0] * o[0] + o[1] * o[1]) + (o[2] * o[2] + o[3] * o[3]);
                        if (xb) { u32x2 w; w.x = cvt_pk_bf16(o[0], o[1]); w.y = cvt_pk_bf16(o[2], o[3]); *(u32x2*)(xb + off + bj * HALF + n * 16) = w; } }
                sq += __shfl_xor(sq, 16); sq += __shfl_xor(sq, 32);
                if (fq == 0) ssq[(size_t)row * 16 + u.pn * 4 + wc] = sq; }
    }
};

template <int ACT> struct EpiRmsBf16 {
    static constexpr bool PERM = true, AFTER_DRAIN = false;
    bf16_t* O; int ldc; const float* ssq; float scale, eps;
    __device__ __forceinline__ void operator()(const f32x4 (&acc)[2][2][4][2], const Unit& u, int wr, int wc, int fr, int fq) const {
        const int row0 = u.pm * BM + wr * 64 + fr, col0 = u.pn * BM + wc * 32 + 8 * fq;
#pragma unroll
        for (int ai = 0; ai < 2; ++ai)
#pragma unroll
            for (int m = 0; m < 4; ++m) { const int row = row0 + ai * HALF + m * 16; const f32x4* sp = (const f32x4*)(ssq + (size_t)row * 16);
                const f32x4 s0 = sp[0], s1 = sp[1], s2 = sp[2], s3 = sp[3]; const f32x4 st = (s0 + s1) + (s2 + s3);
                const float tot = (st[0] + st[1]) + (st[2] + st[3]); const float rs = __builtin_amdgcn_rsqf(tot * (1.0f / 1024.0f) + eps) * scale;
                bf16_t* rowp = O + (size_t)row * ldc + col0;
#pragma unroll
                for (int bj = 0; bj < 2; ++bj) { f32x4 v0 = acc[ai][bj][m][0] * rs, v1 = acc[ai][bj][m][1] * rs;
                    if (ACT == 1) {
#pragma unroll
                        for (int j = 0; j < 4; ++j) { const float a = fmaxf(v0[j], 0.f), b = fmaxf(v1[j], 0.f); v0[j] = a * a; v1[j] = b * b; } }
                    *(u32x4*)(rowp + bj * HALF) = pack8(v0, v1); } }
    }
};

template <class Epi, class Sched, bool ALIGN_EPI = false, bool SP2 = false>
__device__ __forceinline__ void gemm_phase(PG8_LAS unsigned char* lds, const Gemm g, const Sched& S, const Epi& E) {
    const int tid = threadIdx.x, wid = __builtin_amdgcn_readfirstlane(tid >> 6), lane = tid & 63, wr = wid >> 2, wc = wid & 3, fr = lane & 15, fq = lane >> 4;
    const int K = g.K, nt = K / BK;
    unsigned voffA[2], voffB[2];
#pragma unroll
    for (int i = 0; i < 2; ++i) { int R, C; stage_rc(tid * 16 + i * 8192, R, C); const int Rb = Epi::PERM ? ((R & ~31) + perm32(R & 31)) : R;
        voffA[i] = (unsigned)(R * K + C) * 2u; voffB[i] = (unsigned)(Rb * K + C) * 2u; }
    const size_t kstep = (size_t)(BK * 2);
    const size_t hstep = (size_t)HALF * K * 2;
    const size_t tstep = 2 * hstep;
    const unsigned ldsw = (unsigned)wid * 1024u;
    const int aoff = lds_byte(wr * 64 + fr, fq * 8), boff = lds_byte(wc * 32 + fr, fq * 8);
#define PG8_SA(b, h) (((b) * 2 + (h)) * HTB)
#define PG8_SB(b, h) ((4 + (b) * 2 + (h)) * HTB)
#define PG8_STAGE(bufoff, gbase, voff) do { _Pragma("unroll") for (int _i = 0; _i < 2; ++_i) \
        __builtin_amdgcn_global_load_lds((const unsigned*)((const char*)(gbase) + (voff)[_i]), (PG8_LAS unsigned*)(lds + (bufoff) + ldsw + _i * 8192), 16, 0, 0); } while (0)
#define PG8_LDA(dst, b, h) do { _Pragma("unroll") for (int m = 0; m < 4; ++m) _Pragma("unroll") for (int k = 0; k < 2; ++k) dst[m][k] = *(const PG8_LAS bf16x8*)(lds + PG8_SA(b, h) + aoff + m * 2048 + k * 1024); } while (0)
#define PG8_LDB(dst, b, h) do { _Pragma("unroll") for (int n = 0; n < 2; ++n) _Pragma("unroll") for (int k = 0; k < 2; ++k) dst[n][k] = *(const PG8_LAS bf16x8*)(lds + PG8_SB(b, h) + boff + n * 2048 + k * 1024); } while (0)
#define PG8_MMA(ai, bj, At, Bt) do { __builtin_amdgcn_s_setprio(1); _Pragma("unroll") for (int m = 0; m < 4; ++m) _Pragma("unroll") for (int n = 0; n < 2; ++n) _Pragma("unroll") for (int k = 0; k < 2; ++k) \
        acc[ai][bj][m][n] = __builtin_amdgcn_mfma_f32_16x16x32_bf16(Bt[n][k], At[m][k], acc[ai][bj][m][n], 0, 0, 0); __builtin_amdgcn_s_setprio(0); } while (0)
#define PG8_WAIT_V(n) asm volatile("s_waitcnt vmcnt(" #n ")" ::: "memory")
#define PG8_WAIT_L(n) asm volatile("s_waitcnt lgkmcnt(" #n ")" ::: "memory")
#define PG8_BAR __builtin_amdgcn_s_barrier()
#define PG8_SCHED __builtin_amdgcn_sched_barrier(0)
    Unit cur, nxt; int ui = 0;
    if (!S.next(0, cur)) return;
    f32x4 acc[2][2][4][2];
#pragma unroll
    for (int a = 0; a < 2; ++a)
#pragma unroll
        for (int b = 0; b < 2; ++b)
#pragma unroll
            for (int m = 0; m < 4; ++m)
#pragma unroll
                for (int n = 0; n < 2; ++n) acc[a][b][m][n] = (f32x4){0.f, 0.f, 0.f, 0.f};
    bf16x8 At[4][2], B0[2][2], B1[2][2];
    const char* cA = (const char*)g.A + (size_t)cur.pm * tstep; const char* cB = (const char*)g.Bt + (size_t)cur.pn * tstep;
    S.a_ready(cur);
    if constexpr (SP2) {
        PG8_STAGE(PG8_SB(0, 0), cB, voffB); PG8_STAGE(PG8_SB(0, 1), cB + hstep, voffB); PG8_STAGE(PG8_SA(0, 0), cA, voffA); PG8_STAGE(PG8_SA(0, 1), cA + hstep, voffA);
        if (wr == 1) PG8_BAR;
        PG8_WAIT_V(2); PG8_BAR;
        PG8_STAGE(PG8_SB(1, 0), cB + kstep, voffB); PG8_STAGE(PG8_SA(1, 0), cA + kstep, voffA); PG8_STAGE(PG8_SB(1, 1), cB + hstep + kstep, voffB);
        PG8_WAIT_V(6); PG8_BAR;
    } else {
        PG8_STAGE(PG8_SB(0, 0), cB, voffB); PG8_STAGE(PG8_SA(0, 0), cA, voffA); PG8_STAGE(PG8_SB(0, 1), cB + hstep, voffB); PG8_STAGE(PG8_SA(0, 1), cA + hstep, voffA);
        if (wr == 1) PG8_BAR;
        PG8_WAIT_V(4); PG8_BAR;
        PG8_STAGE(PG8_SB(1, 0), cB + kstep, voffB); PG8_STAGE(PG8_SA(1, 0), cA + kstep, voffA); PG8_STAGE(PG8_SB(1, 1), cB + hstep + kstep, voffB);
        PG8_WAIT_V(6); PG8_BAR;
    }
    for (;;) {
        const bool has_next = S.next(ui + 1, nxt);
        const char* nA = has_next ? (const char*)g.A + (size_t)nxt.pm * tstep : cA; const char* nB = has_next ? (const char*)g.Bt + (size_t)nxt.pn * tstep : cB;
        for (int t = 0; t < nt; t += 2) {
            const bool last = (t == nt - 2);
            const char* a1 = cA + (size_t)(t + 1) * kstep;
            const char* a2 = last ? nA : cA + (size_t)(t + 2) * kstep; const char* b2 = last ? nB : cB + (size_t)(t + 2) * kstep;
            const char* a3 = a2 + kstep; const char* b3 = b2 + kstep;
            if (last && has_next) S.a_ready(nxt);
            if constexpr (SP2) {
            PG8_LDB(B0, 0, 0); PG8_LDB(B1, 0, 1); PG8_SCHED; PG8_LDA(At, 0, 0); PG8_STAGE(PG8_SA(1, 1), a1 + hstep, voffA);
            PG8_WAIT_V(8); PG8_WAIT_L(0); PG8_BAR; PG8_MMA(0, 0, At, B0); PG8_MMA(0, 1, At, B1); PG8_BAR; PG8_SCHED;
            PG8_LDA(At, 0, 1); PG8_STAGE(PG8_SB(0, 0), b2, voffB); PG8_STAGE(PG8_SB(0, 1), b2 + hstep, voffB); PG8_STAGE(PG8_SA(0, 0), a2, voffA);
            PG8_WAIT_V(8); PG8_WAIT_L(0); PG8_BAR; PG8_MMA(1, 0, At, B0); PG8_MMA(1, 1, At, B1); PG8_BAR; PG8_SCHED;
            PG8_LDB(B0, 1, 0); PG8_LDB(B1, 1, 1); PG8_SCHED; PG8_LDA(At, 1, 0); PG8_STAGE(PG8_SA(0, 1), a2 + hstep, voffA);
            PG8_WAIT_V(8); PG8_WAIT_L(0); PG8_BAR; PG8_MMA(0, 0, At, B0); PG8_MMA(0, 1, At, B1); PG8_BAR; PG8_SCHED;
            PG8_LDA(At, 1, 1); PG8_STAGE(PG8_SB(1, 0), b3, voffB); PG8_STAGE(PG8_SB(1, 1), b3 + hstep, voffB); PG8_STAGE(PG8_SA(1, 0), a3, voffA);
            PG8_WAIT_V(8); PG8_WAIT_L(0); PG8_BAR; PG8_MMA(1, 0, At, B0); PG8_MMA(1, 1, At, B1); PG8_BAR; PG8_SCHED;
            } else {
            PG8_LDB(B0, 0, 0); PG8_SCHED; PG8_LDA(At, 0, 0); PG8_STAGE(PG8_SA(1, 1), a1 + hstep, voffA);
            PG8_WAIT_L(8); PG8_BAR; PG8_WAIT_L(0); PG8_MMA(0, 0, At, B0); PG8_BAR; PG8_SCHED;
            PG8_LDB(B1, 0, 1); PG8_STAGE(PG8_SB(0, 0), b2, voffB);
            PG8_BAR; PG8_WAIT_L(0); PG8_MMA(0, 1, At, B1); PG8_BAR;
            PG8_LDA(At, 0, 1); PG8_STAGE(PG8_SA(0, 0), a2, voffA);
            PG8_BAR; PG8_WAIT_L(0); PG8_MMA(1, 0, At, B0); PG8_BAR; PG8_SCHED;
            PG8_STAGE(PG8_SB(0, 1), b2 + hstep, voffB);
            PG8_WAIT_V(6); PG8_BAR; PG8_MMA(1, 1, At, B1); PG8_BAR;
            PG8_LDB(B0, 1, 0); PG8_SCHED; PG8_LDA(At, 1, 0); PG8_STAGE(PG8_SA(0, 1), a2 + hstep, voffA);
            PG8_WAIT_L(8); PG8_BAR; PG8_WAIT_L(0); PG8_MMA(0, 0, At, B0); PG8_BAR; PG8_SCHED;
            PG8_LDB(B1, 1, 1); PG8_STAGE(PG8_SB(1, 0), b3, voffB);
            PG8_BAR; PG8_WAIT_L(0); PG8_MMA(0, 1, At, B1); PG8_BAR;
            PG8_LDA(At, 1, 1); PG8_STAGE(PG8_SA(1, 0), a3, voffA);
            PG8_BAR; PG8_WAIT_L(0); PG8_MMA(1, 0, At, B0); PG8_BAR; PG8_SCHED;
            PG8_STAGE(PG8_SB(1, 1), b3 + hstep, voffB);
            PG8_WAIT_V(6); PG8_BAR; PG8_MMA(1, 1, At, B1); PG8_BAR;
            }
        }
        if constexpr (ALIGN_EPI) { if (wr == 0) PG8_BAR; }
        if constexpr (!Epi::AFTER_DRAIN) { E(acc, cur, wr, wc, fr, fq); S.done(cur); }
        if (!has_next) break;
#pragma unroll
        for (int a = 0; a < 2; ++a)
#pragma unroll
            for (int b = 0; b < 2; ++b)
#pragma unroll
                for (int m = 0; m < 4; ++m)
#pragma unroll
                    for (int n = 0; n < 2; ++n) acc[a][b][m][n] = (f32x4){0.f, 0.f, 0.f, 0.f};
        cur = nxt; cA = nA; cB = nB; ++ui;
        if constexpr (ALIGN_EPI) { if (wr == 1) PG8_BAR; }
    }
    PG8_WAIT_V(0);
    if constexpr (!ALIGN_EPI) { if (wr == 0) PG8_BAR; }
    PG8_BAR;
    if constexpr (Epi::AFTER_DRAIN) { E.fused(acc, cur, wr, wc, fr, fq, lds, wid, lane); S.done(cur); }
#undef PG8_SA
#undef PG8_SB
#undef PG8_STAGE
#undef PG8_LDA
#undef PG8_LDB
#undef PG8_MMA
#undef PG8_WAIT_V
#undef PG8_WAIT_L
#undef PG8_BAR
#undef PG8_SCHED
}
}

#define GAS __attribute__((address_space(1)))
#define LAS __attribute__((address_space(3)))
typedef unsigned short bf16;
typedef unsigned v4u __attribute__((ext_vector_type(4)));
typedef float f32x4 __attribute__((ext_vector_type(4)));
typedef short bf16x8 __attribute__((ext_vector_type(8)));
typedef GAS unsigned gu32;
typedef GAS unsigned long long gu64;
#define RLX_AGENT __ATOMIC_RELAXED, __HIP_MEMORY_SCOPE_AGENT
#define LDS_WAIT() asm volatile("s_waitcnt lgkmcnt(0)" ::: "memory")
#define VM_WAIT() asm volatile("s_waitcnt vmcnt(0)" ::: "memory")
__device__ __forceinline__ unsigned long long rt() { return __builtin_amdgcn_s_memrealtime(); }
__device__ __forceinline__ unsigned f2bf(float f) { unsigned u = __builtin_bit_cast(unsigned, f); return (u + 0x7fffu + ((u >> 16) & 1u)) >> 16; }
__device__ __forceinline__ unsigned pk2(float lo, float hi) { return f2bf(lo) | (f2bf(hi) << 16); }

#define XB_TMO      128
#define XB_XCNT(j)  (256  + 64 * (j))
#define XB_XSUB(j)  (1280 + 64 * (j))
#define XB_XGEN(j)  (2304 + 64 * (j))
#define XB_TOP      3328
#define XB_TOPGEN   3392
#define XCD_BAR_WORDS 3456
#define XB_SPIN_CAP (1u << 18)

__device__ __forceinline__ unsigned xb_ld(unsigned* p)              { return __hip_atomic_load(p, __ATOMIC_RELAXED, __HIP_MEMORY_SCOPE_AGENT); }
__device__ __forceinline__ unsigned xb_add(unsigned* p, unsigned v) { return __hip_atomic_fetch_add(p, v, __ATOMIC_RELAXED, __HIP_MEMORY_SCOPE_AGENT); }
__device__ __forceinline__ unsigned xb_xcc_id() { return (unsigned)__builtin_amdgcn_s_getreg((3 << 11) | 20) & 0xFu; }
#define XB_SPIN(cond, bar) do { unsigned _sp = 0; while (cond) { __builtin_amdgcn_s_sleep(1); \
    if ((++_sp & 255u) == 0u) { if (xb_ld(&(bar)[XB_TMO])) break; if (_sp > XB_SPIN_CAP) { atomicAdd(&(bar)[XB_TMO], 1u); break; } } } } while (0)

struct XcdBarrier {
    unsigned* bar; unsigned x;
    volatile LAS unsigned* st;
};

__device__ __forceinline__ XcdBarrier xcd_barrier_post(unsigned* bar, volatile LAS unsigned* st) {
    XcdBarrier b; b.bar = bar; b.x = xb_xcc_id(); b.st = st;
    if (threadIdx.x == 0) (void)xb_add(&bar[XB_XCNT(b.x)], 1u);
    return b;
}
__device__ __forceinline__ void xcd_barrier_complete(unsigned* bar, unsigned x, unsigned& nloc, unsigned& nx) {
    const unsigned G = gridDim.x * gridDim.y * gridDim.z;
    unsigned sum, cnt, mine, sp = 0u;
    for (;;) {
        sum = 0u; cnt = 0u; mine = 0u;
#pragma unroll
        for (unsigned j = 0; j < 16; ++j) { const unsigned c = xb_ld(&bar[XB_XCNT(j)]); sum += c; cnt += (c > 0u) ? 1u : 0u; mine = (j == x) ? c : mine; }
        if (sum == G) break;
        __builtin_amdgcn_s_sleep(1);
        if ((++sp & 255u) == 0u) { if (xb_ld(&bar[XB_TMO])) break; if (sp > XB_SPIN_CAP) { atomicAdd(&bar[XB_TMO], 1u); break; } }
    }
    nloc = mine > 0u ? mine : 1u; nx = cnt > 0u ? cnt : 1u;
}

__device__ __forceinline__ void xcd_barrier(const XcdBarrier& b) {
    asm volatile("s_waitcnt vmcnt(0)" ::: "memory");
    __syncthreads();
    if (threadIdx.x == 0) {
        unsigned* bar = b.bar;
        __builtin_amdgcn_s_waitcnt(0);
        unsigned nloc = b.st[0], nx = b.st[1];
        if (nloc == 0u) { xcd_barrier_complete(bar, b.x, nloc, nx); b.st[0] = nloc; b.st[1] = nx; }
        const unsigned old = xb_add(&bar[XB_XSUB(b.x)], 1u);
        const unsigned gen = old / nloc;
        if (old + 1u == (gen + 1u) * nloc) {
            __builtin_amdgcn_fence(__ATOMIC_RELEASE, "agent");
            asm volatile("s_waitcnt vmcnt(0)" ::: "memory");
            const unsigned og = xb_add(&bar[XB_TOP], 1u);
            const unsigned tg = og / nx;
            if (og + 1u == (tg + 1u) * nx) xb_add(&bar[XB_TOPGEN], 1u);
            else XB_SPIN(xb_ld(&bar[XB_TOPGEN]) == tg, bar);
            __builtin_amdgcn_fence(__ATOMIC_ACQUIRE, "agent");
            xb_add(&bar[XB_XGEN(b.x)], 1u);
            asm volatile("s_waitcnt vmcnt(0)" ::: "memory");
        } else {
            XB_SPIN(xb_ld(&bar[XB_XGEN(b.x)]) == gen, bar);
            __builtin_amdgcn_fence(__ATOMIC_ACQUIRE, "agent");
            asm volatile("s_waitcnt vmcnt(0)" ::: "memory");
        }
    }
    __syncthreads();
}


constexpr int BATCH = 2, SEQ = 8192, D = 1024, M = BATCH * SEQ;
constexpr int NMEM = 256, MROWS = BATCH * NMEM;
constexpr int NIN = 8192, ZW = 4608, CCH = 768, GW = 2048, AOUT = 512, FF = 4096, CONVK = 31;
constexpr float EPS = 1e-6f;
constexpr float LOG2E = 1.4426950408889634f;
constexpr float QSCALE = 0.08838834764831845f * LOG2E;
constexpr float CQSCALE = 0.0625f * LOG2E;
constexpr int NWAVES = 8;

constexpr size_t MiB = 1u << 20;
constexpr size_t WS_CTL = 0, CTL_ZERO_BYTES = 64 * 1024;
constexpr size_t WS_ROPE = 1 * MiB;
constexpr size_t WS_SSQ1 = 2 * MiB, WS_SSQ2 = 3 * MiB, WS_SSQ3 = 4 * MiB;
constexpr size_t WS_LSE = 5 * MiB;
constexpr size_t WS_MN = 6 * MiB;
constexpr size_t WS_CKV = 7 * MiB;
constexpr size_t WS_WAP = 9 * MiB, WS_WCP = 10 * MiB, WS_WOUT = 12 * MiB, WS_WCQ = 14 * MiB, WS_WCO = 16 * MiB, WS_WUP = 18 * MiB, WS_WDN = 26 * MiB;
constexpr size_t WS_WCKV = 34 * MiB, WS_WIN = 38 * MiB, WS_XN = 54 * MiB;
constexpr size_t WS_OG = 38 * MiB;
constexpr size_t WS_Z = 86 * MiB;
constexpr size_t WS_C = 230 * MiB;
constexpr size_t WS_ATTN = 86 * MiB, WS_C2 = 102 * MiB;
constexpr size_t WS_MERGED = 126 * MiB, WS_TMP = 158 * MiB;
constexpr size_t WS_X1B = 38 * MiB, WS_CQ = 70 * MiB, WS_CO = 102 * MiB, WS_X2B = 38 * MiB, WS_H = 86 * MiB;
constexpr size_t WS_END = 256 * MiB;
static_assert(WS_C + (size_t)M * CCH * 2 <= WS_END && WS_H + (size_t)M * FF * 2 <= WS_END && WS_TMP + (size_t)M * D * 4 <= WS_C, "ws map");
constexpr int CW_BAR = 4096;

constexpr int RING_OFF = 0, RING_BYTES = 131072;
constexpr int LDSCTL_OFF = RING_BYTES, MISC_OFF = LDSCTL_OFF + 320;
constexpr int LDS_BYTES = 147456;

struct Frame {
    LAS unsigned char* lds;
    volatile LAS unsigned* MISC;
    gu32* ctl;
    int tid, lane, wave;
    int vcu, G;
};

__device__ __forceinline__ float wave_sum(float v) {
#pragma unroll
    for (int o = 1; o < 64; o <<= 1) v += __shfl_xor(v, o);
    return v;
}

__device__ __forceinline__ int win_dst(int n) {
    if (n < 3072) { const int d = n & 127; if (d < 32) return (n & ~127) + 8 * ((d & 15) >> 2) + 4 * (d >> 4) + (d & 3); return n; }
    if (n < 4608) return n;
    if (n < 5376) { const int ch = n - 4608; return 4608 + 256 * (ch >> 7) + (ch & 127); }
    if (n < 6144) { const int ch = n - 5376; return 4608 + 256 * (ch >> 7) + 128 + (ch & 127); }
    return n;
}
template <int MODE>
__device__ __forceinline__ void p0_transpose_item(const float* W, int K, int N, bf16* WT, const float* sc, LAS float* scr, int item, int lane) {
    const int nblk = N / 32, kb = item / nblk, nb = item % nblk, k0 = 64 * kb, n0 = 32 * nb;
#pragma unroll 8
    for (int i = 0; i < 32; ++i) { const int kk = 2 * i + (lane >> 5); float v = W[(size_t)(k0 + kk) * N + n0 + (lane & 31)]; if (sc) v *= sc[k0 + kk]; scr[kk * 33 + (lane & 31)] = v; }
    LDS_WAIT(); asm volatile("" ::: "memory");
    const int c = lane & 7;
#pragma unroll
    for (int j = 0; j < 4; ++j) { const int n = (lane >> 3) + 8 * j; const LAS float* s = scr + (8 * c) * 33 + n;
        v4u o; o.x = pk2(s[0 * 33], s[1 * 33]); o.y = pk2(s[2 * 33], s[3 * 33]); o.z = pk2(s[4 * 33], s[5 * 33]); o.w = pk2(s[6 * 33], s[7 * 33]);
        const int rowd = MODE == 1 ? win_dst(n0 + n) : (n0 + n);
        *(GAS v4u*)(WT + (size_t)rowd * K + k0 + 8 * c) = o; }
    LDS_WAIT(); asm volatile("" ::: "memory");
}
__device__ __forceinline__ void rms_row_to_bf16(int lane, const float* xrow, const float* g, bf16* orow) {
    const GAS f32x4* xr = (const GAS f32x4*)xrow + lane; const GAS f32x4* gr = (const GAS f32x4*)g + lane;
    f32x4 v[4]; float s = 0.f;
#pragma unroll
    for (int j = 0; j < 4; ++j) { v[j] = xr[64 * j]; s += (v[j].x * v[j].x + v[j].y * v[j].y) + (v[j].z * v[j].z + v[j].w * v[j].w); }
    const float rstd = 1.0f / sqrtf(wave_sum(s) * (1.f / D) + EPS);
    GAS unsigned long long* o8 = (GAS unsigned long long*)orow + lane;
#pragma unroll
    for (int j = 0; j < 4; ++j) { const f32x4 gg = gr[64 * j];
        o8[64 * j] = (unsigned long long)pk2(v[j].x * rstd * gg.x, v[j].y * rstd * gg.y) | ((unsigned long long)pk2(v[j].z * rstd * gg.z, v[j].w * rstd * gg.w) << 32); }
}
__device__ const float ROPE_INV_FREQ[16] = {1.0f, 0.44036659598350525f, 0.1939227432012558f, 0.08539710193872452f, 0.03760603070259094f, 0.01656043902039528f, 0.007292664609849453f, 0.0032114458736032248f,
    0.0014142135623842478f, 0.000622772378847003f, 0.00027424818836152554f, 0.00012076973507646471f, 5.318296098266728e-05f, 2.34199997066753e-05f, 1.0313386155758053e-05f, 4.541670477919979e-06f};
__device__ __forceinline__ void rope_entry(int idx, float* cs) {
    const int i = idx & 15, pos = idx >> 4;
    const float ang = (float)pos * ROPE_INV_FREQ[i];
    const double rev4 = (double)ang * 0.63661977236758134308;
    const double q = __builtin_rint(rev4); const double y = (rev4 - q) * 1.57079632679489661923; const double y2 = y * y;
    double sn = y * (1.0 + y2 * (-1.0 / 6 + y2 * (1.0 / 120 + y2 * (-1.0 / 5040 + y2 * (1.0 / 362880 + y2 * (-1.0 / 39916800))))));
    double cn = 1.0 + y2 * (-0.5 + y2 * (1.0 / 24 + y2 * (-1.0 / 720 + y2 * (1.0 / 40320 + y2 * (-1.0 / 3628800 + y2 * (1.0 / 479001600))))));
    const int qi = ((int)(long long)q) & 3;
    double c, s;
    if (qi == 0) { c = cn; s = sn; } else if (qi == 1) { c = -sn; s = cn; } else if (qi == 2) { c = -cn; s = -sn; } else { c = sn; s = -cn; }
    cs[2 * idx] = (float)c; cs[2 * idx + 1] = (float)s;
}

typedef float f32x16 __attribute__((ext_vector_type(16)));
typedef short s16x4 __attribute__((ext_vector_type(4)));
typedef short v4i16_t __attribute__((ext_vector_type(4)));
__device__ __forceinline__ unsigned offb(unsigned row, unsigned ch) { return 256u * row + 16u * (ch ^ (((row & 3) << 2) | ((row >> 2) & 3))); }
__device__ __forceinline__ s16x4 vtr(LAS const unsigned char* p) { return __builtin_bit_cast(s16x4, __builtin_amdgcn_ds_read_tr16_b64_v4i16((LAS v4i16_t*)p)); }
__device__ __forceinline__ unsigned cvtpk(float lo, float hi) { return pg8::cvt_pk_bf16(lo, hi); }
__device__ __forceinline__ unsigned tr_addr(int lane, unsigned rowbase, unsigned c, unsigned t) {
    const unsigned h = lane >> 5, blk = (lane >> 4) & 1, q = (lane & 15) >> 2, p = lane & 3;
    return offb(rowbase + 8 * t + 4 * h + q, 4 * c + 2 * blk + (p >> 1)) + 8 * (p & 1);
}

template <int NC>
__device__ __forceinline__ void softmax_pv(f32x16& s, float& m_run, float& l_run, f32x16 (&oT)[NC], LAS const unsigned char* vimg, unsigned rowbase, int lane) {
    float tm = s[0];
#pragma unroll
    for (int i = 1; i < 16; ++i) tm = fmaxf(tm, s[i]);
    tm = fmaxf(tm, __shfl_xor(tm, 32));
    const float mn = fmaxf(m_run, tm);
    const float alpha = __builtin_amdgcn_exp2f(m_run - mn);
    float rs = 0.f;
#pragma unroll
    for (int i = 0; i < 16; ++i) { s[i] = __builtin_amdgcn_exp2f(s[i] - mn); rs += s[i]; }
    rs += __shfl_xor(rs, 32);
    l_run = l_run * alpha + rs; m_run = mn;
#pragma unroll
    for (int c = 0; c < NC; ++c)
#pragma unroll
        for (int i = 0; i < 16; ++i) oT[c][i] *= alpha;
    bf16x8 pf[2];
#pragma unroll
    for (int ks = 0; ks < 2; ++ks) { v4u w; w.x = cvtpk(s[8 * ks + 0], s[8 * ks + 1]); w.y = cvtpk(s[8 * ks + 2], s[8 * ks + 3]); w.z = cvtpk(s[8 * ks + 4], s[8 * ks + 5]); w.w = cvtpk(s[8 * ks + 6], s[8 * ks + 7]);
        pf[ks] = __builtin_bit_cast(bf16x8, w); }
#pragma unroll
    for (int c = 0; c < NC; ++c)
#pragma unroll
        for (int ks = 0; ks < 2; ++ks) {
            LAS const unsigned char* img = vimg + (c >> 2) * 65536;
            const s16x4 lo = vtr(img + tr_addr(lane, rowbase + 16 * ks, c & 3, 0)), hi = vtr(img + tr_addr(lane, rowbase + 16 * ks, c & 3, 1));
            const bf16x8 vf = (bf16x8){lo[0], lo[1], lo[2], lo[3], hi[0], hi[1], hi[2], hi[3]};
            oT[c] = __builtin_amdgcn_mfma_f32_32x32x16_bf16(vf, pf[ks], oT[c], 0, 0, 0);
        }
}

__device__ __forceinline__ void dil_attn_unit(Frame& F, int unit, const bf16* Z, bf16* OG, float* LSE) {
    int idx = unit; const int n2r = idx & 31; idx >>= 5; const int h = idx & 3; idx >>= 2; const int g = idx % 3, b = idx / 3;
    const int dsh = 2 * g, dil = 1 << dsh, nb2 = (SEQ >> dsh) >> 8;
    const int r = n2r / nb2, n2 = n2r % nb2, m0 = 256 * n2;
    const int hd = g * 4 + h;
    const bf16* Zb = Z + (size_t)b * SEQ * ZW;
    const int lane = F.lane, w = F.wave, ql = lane & 31, hi = lane >> 5;
    LAS unsigned char* vimg = F.lds + RING_OFF;
    for (int i = F.tid; i < 384 * 16; i += NWAVES * 64) { const int row = i >> 4, ch = i & 15; const int mk = m0 - 128 + row;
        v4u v = {0u, 0u, 0u, 0u};
        if (mk >= 0) v = *(const GAS v4u*)(Zb + (size_t)(mk * dil + r) * ZW + 3072 + hd * 128 + ch * 8);
        *(LAS v4u*)(vimg + offb(row, ch)) = v; }
    __syncthreads();
    const int mq = m0 + 32 * w + ql;
    const bf16* qrow = Zb + (size_t)(mq * dil + r) * ZW + hd * 128 + 8 * hi;
    bf16x8 qf[8];
#pragma unroll
    for (int ks = 0; ks < 8; ++ks) qf[ks] = *(const GAS bf16x8*)(qrow + 16 * ks);
    float m_run = -1e30f, l_run = 0.f; f32x16 oT[4];
#pragma unroll
    for (int c = 0; c < 4; ++c) oT[c] = (f32x16){0.f, 0.f, 0.f, 0.f, 0.f, 0.f, 0.f, 0.f, 0.f, 0.f, 0.f, 0.f, 0.f, 0.f, 0.f, 0.f};
#pragma unroll 1
    for (int kt = 0; kt < 5; ++kt) {
        const int mk0 = m0 + 32 * w - 128 + 32 * kt;
        if (mk0 < 0) continue;
        const bf16* krow = Zb + (size_t)((mk0 + ql) * dil + r) * ZW + 1536 + hd * 128 + 8 * hi;
        bf16x8 kf[8];
#pragma unroll
        for (int ks = 0; ks < 8; ++ks) kf[ks] = *(const GAS bf16x8*)(krow + 16 * ks);
        f32x16 s = (f32x16){0.f, 0.f, 0.f, 0.f, 0.f, 0.f, 0.f, 0.f, 0.f, 0.f, 0.f, 0.f, 0.f, 0.f, 0.f, 0.f};
#pragma unroll
        for (int ks = 0; ks < 8; ++ks) s = __builtin_amdgcn_mfma_f32_32x32x16_bf16(kf[ks], qf[ks], s, 0, 0, 0);
        if (kt == 0) {
#pragma unroll
            for (int i = 0; i < 16; ++i) { const int ko = (i & 3) + 8 * (i >> 2) + 4 * hi; if (ko < ql) s[i] = -1e30f; }
        } else if (kt == 4) {
#pragma unroll
            for (int i = 0; i < 16; ++i) { const int ko = (i & 3) + 8 * (i >> 2) + 4 * hi; if (ko > ql) s[i] = -1e30f; }
        }
        softmax_pv<4>(s, m_run, l_run, oT, vimg, (unsigned)(32 * w + 32 * kt), lane);
    }
    const float inv = 1.0f / l_run;
    const size_t orow = (size_t)b * SEQ + (size_t)(mq * dil + r);
    bf16* op = OG + ((size_t)g * M + orow) * AOUT + h * 128 + 4 * hi;
#pragma unroll
    for (int c = 0; c < 4; ++c)
#pragma unroll
        for (int i4 = 0; i4 < 4; ++i4) { pg8::u32x2 wv; wv.x = cvtpk(oT[c][4 * i4] * inv, oT[c][4 * i4 + 1] * inv); wv.y = cvtpk(oT[c][4 * i4 + 2] * inv, oT[c][4 * i4 + 3] * inv);
            *(GAS pg8::u32x2*)(op + 32 * c + 8 * i4) = wv; }
    if (hi == 0) LSE[((size_t)g * M + orow) * 4 + h] = m_run + __builtin_amdgcn_logf(l_run);
    __syncthreads();
}

constexpr int CV_T = 16, CV_ROWS = CV_T + 30, CV_OUT_OFF = 73728;
__device__ __forceinline__ void conv_unit(Frame& F, int unit, const bf16* C, const float* cw, const float* cb, const float* lg, const float* lb, bf16* C2) {
    const int b = unit >> 9, t0 = (unit & 511) * CV_T;
    const bf16* Cb = C + (size_t)b * SEQ * CCH;
    LAS unsigned char* st = F.lds + RING_OFF;
    for (int i = F.tid; i < CV_ROWS * 96; i += NWAVES * 64) { const int row = i / 96, ch = i % 96; const int t = t0 - 30 + row;
        v4u v = {0u, 0u, 0u, 0u};
        if (t >= 0) v = *(const GAS v4u*)(Cb + (size_t)t * CCH + ch * 8);
        *(LAS v4u*)(st + row * 1536 + ch * 16) = v; }
    __syncthreads();
    const int cp = F.tid;
    if (cp < 384) {
        pg8::f32x2 wt[CONVK];
#pragma unroll
        for (int j = 0; j < CONVK; ++j) wt[j] = *(const GAS pg8::f32x2*)(cw + j * CCH + 2 * cp);
        const pg8::f32x2 bias = *(const GAS pg8::f32x2*)(cb + 2 * cp);
#pragma unroll 1
        for (int ob = 0; ob < CV_T / 4; ++ob) {
            pg8::f32x2 a[4] = {bias, bias, bias, bias};
            LAS const unsigned char* sp = st + (4 * ob) * 1536 + 4 * cp;
#pragma unroll
            for (int rr = 0; rr < 34; ++rr) {
                const unsigned pk = *(const LAS unsigned*)(sp + rr * 1536);
                pg8::f32x2 x; x.x = __uint_as_float(pk << 16); x.y = __uint_as_float(pk & 0xffff0000u);
#pragma unroll
                for (int k = 0; k < 4; ++k) { const int j = rr - k; if (j >= 0 && j < CONVK) a[k] += wt[j < 0 ? 0 : (j >= CONVK ? 0 : j)] * x; }
            }
#pragma unroll
            for (int k = 0; k < 4; ++k) *(LAS pg8::f32x2*)(st + CV_OUT_OFF + ((4 * ob + k) * CCH + 2 * cp) * 4) = a[k];
        }
    }
    __syncthreads();
#pragma unroll 1
    for (int o = F.wave; o < CV_T; o += NWAVES) {
        f32x4 v[3]; float s = 0.f;
#pragma unroll
        for (int k = 0; k < 3; ++k) { v[k] = *(const LAS f32x4*)(st + CV_OUT_OFF + (o * CCH + 4 * F.lane + 256 * k) * 4); s += (v[k].x + v[k].y) + (v[k].z + v[k].w); }
        const float mean = wave_sum(s) * (1.0f / CCH); float s2 = 0.f;
#pragma unroll
        for (int k = 0; k < 3; ++k) { v[k] = v[k] - mean; s2 += (v[k].x * v[k].x + v[k].y * v[k].y) + (v[k].z * v[k].z + v[k].w * v[k].w); }
        const float rstd = 1.0f / sqrtf(wave_sum(s2) * (1.0f / CCH) + EPS);
        bf16* orow = C2 + ((size_t)b * SEQ + t0 + o) * CCH;
#pragma unroll
        for (int k = 0; k < 3; ++k) { const int ch = 4 * F.lane + 256 * k; const f32x4 gg = *(const GAS f32x4*)(lg + ch), bb = *(const GAS f32x4*)(lb + ch);
            f32x4 y = v[k] * rstd * gg + bb;
#pragma unroll
            for (int j = 0; j < 4; ++j) y[j] = y[j] * pg8::sigmoidf_fast(y[j]);
            pg8::u32x2 wv; wv.x = cvtpk(y[0], y[1]); wv.y = cvtpk(y[2], y[3]); *(GAS pg8::u32x2*)(orow + ch) = wv; }
    }
    __syncthreads();
}

__device__ __forceinline__ void merge_item(Frame& F, int item, const bf16* OG, const float* LSE, bf16* ATT) {
#pragma unroll 1
    for (int i = 0; i < 8; ++i) {
        const size_t tok = (size_t)item * 64 + F.wave * 8 + i; const int hh = F.lane >> 4;
        const float l0 = LSE[(0 * (size_t)M + tok) * 4 + hh], l1 = LSE[(1 * (size_t)M + tok) * 4 + hh], l2 = LSE[(2 * (size_t)M + tok) * 4 + hh];
        const float mx = fmaxf(l0, fmaxf(l1, l2));
        float w0 = __builtin_amdgcn_exp2f(l0 - mx), w1 = __builtin_amdgcn_exp2f(l1 - mx), w2 = __builtin_amdgcn_exp2f(l2 - mx);
        const float inv = 1.0f / (w0 + w1 + w2); w0 *= inv; w1 *= inv; w2 *= inv;
        const v4u a = *(const GAS v4u*)(OG + (0 * (size_t)M + tok) * AOUT + 8 * F.lane), bq = *(const GAS v4u*)(OG + (1 * (size_t)M + tok) * AOUT + 8 * F.lane), cq = *(const GAS v4u*)(OG + (2 * (size_t)M + tok) * AOUT + 8 * F.lane);
        v4u o;
#pragma unroll
        for (int k = 0; k < 4; ++k) {
            const float lo = w0 * __uint_as_float(a[k] << 16) + w1 * __uint_as_float(bq[k] << 16) + w2 * __uint_as_float(cq[k] << 16);
            const float hi = w0 * __uint_as_float(a[k] & 0xffff0000u) + w1 * __uint_as_float(bq[k] & 0xffff0000u) + w2 * __uint_as_float(cq[k] & 0xffff0000u);
            o[k] = cvtpk(lo, hi); }
        *(GAS v4u*)(ATT + tok * AOUT + 8 * F.lane) = o;
    }
}

__device__ __forceinline__ void cross_attn_unit(Frame& F, int unit, const bf16* CQ, const bf16* CKV, bf16* CO) {
    const int qb = unit & 31, hd = (unit >> 5) & 3, b = unit >> 7;
    const int lane = F.lane, w = F.wave, ql = lane & 31, hi = lane >> 5;
    LAS unsigned char* vimg = F.lds + RING_OFF;
    const bf16* KVb = CKV + (size_t)b * NMEM * 2048;
    for (int i = F.tid; i < 256 * 32; i += NWAVES * 64) { const int row = i >> 5, c32 = i & 31;
        const v4u v = *(const GAS v4u*)(KVb + (size_t)row * 2048 + 1024 + hd * 256 + c32 * 8);
        *(LAS v4u*)(vimg + (c32 >> 4) * 65536 + offb(row, c32 & 15)) = v; }
    __syncthreads();
    const size_t qrowi = (size_t)b * SEQ + qb * 256 + 32 * w + ql;
    const bf16* qrow = CQ + qrowi * D + hd * 256 + 8 * hi;
    float m_run = -1e30f, l_run = 0.f; f32x16 oT[8];
#pragma unroll
    for (int c = 0; c < 8; ++c) oT[c] = (f32x16){0.f, 0.f, 0.f, 0.f, 0.f, 0.f, 0.f, 0.f, 0.f, 0.f, 0.f, 0.f, 0.f, 0.f, 0.f, 0.f};
#pragma unroll 1
    for (int kt = 0; kt < 8; ++kt) {
        const bf16* krow = KVb + (size_t)(32 * kt + ql) * 2048 + hd * 256 + 8 * hi;
        f32x16 s = (f32x16){0.f, 0.f, 0.f, 0.f, 0.f, 0.f, 0.f, 0.f, 0.f, 0.f, 0.f, 0.f, 0.f, 0.f, 0.f, 0.f};
#pragma unroll 1
        for (int kc = 0; kc < 4; ++kc) {
            bf16x8 kf[4], qf[4];
#pragma unroll
            for (int ks = 0; ks < 4; ++ks) { kf[ks] = *(const GAS bf16x8*)(krow + 64 * kc + 16 * ks); qf[ks] = *(const GAS bf16x8*)(qrow + 64 * kc + 16 * ks); }
#pragma unroll
            for (int ks = 0; ks < 4; ++ks) s = __builtin_amdgcn_mfma_f32_32x32x16_bf16(kf[ks], qf[ks], s, 0, 0, 0);
        }
        softmax_pv<8>(s, m_run, l_run, oT, vimg, (unsigned)(32 * kt), lane);
    }
    const float inv = 1.0f / l_run;
    bf16* op = CO + qrowi * D + hd * 256 + 4 * hi;
#pragma unroll
    for (int c = 0; c < 8; ++c)
#pragma unroll
        for (int i4 = 0; i4 < 4; ++i4) { pg8::u32x2 wv; wv.x = cvtpk(oT[c][4 * i4] * inv, oT[c][4 * i4 + 1] * inv); wv.y = cvtpk(oT[c][4 * i4 + 2] * inv, oT[c][4 * i4 + 3] * inv);
            *(GAS pg8::u32x2*)(op + 32 * c + 8 * i4) = wv; }
    __syncthreads();
}

struct Args { const float* in[21]; float* out; unsigned char* ws; int ph_lo, ph_hi; };
typedef const __attribute__((address_space(4))) Args* ArgP;
__device__ __forceinline__ ArgP argp() { ArgP p = (ArgP)__builtin_amdgcn_kernarg_segment_ptr(); asm volatile("" : "+s"(p)); return p; }
#define WSP(T, off) ((T*)(A->ws + (off)))

__device__ __forceinline__ void ph0(Frame& F) {
    ArgP A = argp();
    const int gw = F.vcu * NWAVES + F.wave, NGW = F.G * NWAVES;
    LAS float* scr = (LAS float*)(F.lds + RING_OFF + F.wave * 16384);
    constexpr int I_IN = (D / 64) * (NIN / 32), I_AP = (AOUT / 64) * (D / 32), I_CP = (CCH / 64) * (D / 32), I_SQ = (D / 64) * (D / 32), I_CKV = (D / 64) * (2 * D / 32), I_UP = (D / 64) * (FF / 32), I_DN = (FF / 64) * (D / 32);
    constexpr int NITEMS = I_IN + I_AP + I_CP + 3 * I_SQ + I_CKV + I_UP + I_DN;
#pragma unroll 1
    for (int it = gw; it < NITEMS; it += NGW) {
        int r = it;
        if (r < I_IN) { p0_transpose_item<1>(A->in[3], D, NIN, WSP(bf16, WS_WIN), nullptr, scr, r, F.lane); continue; } r -= I_IN;
        if (r < I_AP) { p0_transpose_item<0>(A->in[9], AOUT, D, WSP(bf16, WS_WAP), nullptr, scr, r, F.lane); continue; } r -= I_AP;
        if (r < I_CP) { p0_transpose_item<0>(A->in[10], CCH, D, WSP(bf16, WS_WCP), nullptr, scr, r, F.lane); continue; } r -= I_CP;
        if (r < I_SQ) { p0_transpose_item<0>(A->in[11], D, D, WSP(bf16, WS_WOUT), nullptr, scr, r, F.lane); continue; } r -= I_SQ;
        if (r < I_SQ) { p0_transpose_item<0>(A->in[14], D, D, WSP(bf16, WS_WCQ), A->in[12], scr, r, F.lane); continue; } r -= I_SQ;
        if (r < I_SQ) { p0_transpose_item<0>(A->in[16], D, D, WSP(bf16, WS_WCO), nullptr, scr, r, F.lane); continue; } r -= I_SQ;
        if (r < I_CKV) { p0_transpose_item<0>(A->in[15], D, 2 * D, WSP(bf16, WS_WCKV), nullptr, scr, r, F.lane); continue; } r -= I_CKV;
        if (r < I_UP) { p0_transpose_item<0>(A->in[18], D, FF, WSP(bf16, WS_WUP), A->in[17], scr, r, F.lane); continue; } r -= I_UP;
        p0_transpose_item<0>(A->in[19], FF, D, WSP(bf16, WS_WDN), nullptr, scr, r, F.lane);
    }
#pragma unroll 1
    for (int m = gw; m < M; m += NGW) rms_row_to_bf16(F.lane, A->in[0] + (size_t)m * D, A->in[2], WSP(bf16, WS_XN) + (size_t)m * D);
#pragma unroll 1
    for (int m = gw; m < MROWS; m += NGW) rms_row_to_bf16(F.lane, A->in[1] + (size_t)m * D, A->in[13], WSP(bf16, WS_MN) + (size_t)m * D);
#pragma unroll 1
    for (int i = F.vcu * (NWAVES * 64) + F.tid; i < SEQ * 16; i += F.G * NWAVES * 64) rope_entry(i, WSP(float, WS_ROPE));
}
__device__ __forceinline__ void ph1(Frame& F) {
    ArgP A = argp();
    pg8::Gemm g{WSP(bf16, WS_XN), WSP(bf16, WS_WIN), M, NIN, D}; pg8::StaticOrder S; S.init(M, NIN, F.G, (int)blockIdx.x);
    pg8::EpiG1 E{WSP(bf16, WS_Z), WSP(bf16, WS_C), (bf16*)A->out, WSP(float, WS_ROPE), A->in[4], QSCALE};
    pg8::gemm_phase<pg8::EpiG1, pg8::StaticOrder, true, true>(F.lds + RING_OFF, g, S, E);
}
__device__ __forceinline__ void ph2(Frame& F) {
    ArgP A = argp();
#pragma unroll 1
    for (int u = F.vcu; u < 768; u += F.G) dil_attn_unit(F, u, WSP(bf16, WS_Z), WSP(bf16, WS_OG), WSP(float, WS_LSE));
}
__device__ __forceinline__ void ph3(Frame& F) {
    ArgP A = argp();
    const int NG = F.G >= 32 ? 16 : 0;
    if ((int)blockIdx.x < NG || NG == 0) {
        pg8::Gemm g{WSP(bf16, WS_MN), WSP(bf16, WS_WCKV), MROWS, 2 * D, D}; pg8::StaticOrder S; S.init(MROWS, 2 * D, NG ? NG : F.G, (int)blockIdx.x);
        pg8::EpiPlainBf16 E{WSP(bf16, WS_CKV), 2 * D};
        pg8::gemm_phase<pg8::EpiPlainBf16, pg8::StaticOrder, true, true>(F.lds + RING_OFF, g, S, E);
    }
    if ((int)blockIdx.x >= NG) {
        const int wi = (int)blockIdx.x - NG, nw = F.G - NG;
#pragma unroll 1
        for (int u = wi; u < M / CV_T; u += nw) conv_unit(F, u, WSP(bf16, WS_C), A->in[5], A->in[6], A->in[7], A->in[8], WSP(bf16, WS_C2));
#pragma unroll 1
        for (int u = wi; u < 256; u += nw) merge_item(F, u, WSP(bf16, WS_OG), WSP(float, WS_LSE), WSP(bf16, WS_ATTN));
    }
}
__device__ __forceinline__ void ph4(Frame& F) {
    { ArgP A = argp();
      pg8::Gemm g{WSP(bf16, WS_ATTN), WSP(bf16, WS_WAP), M, D, AOUT}; pg8::StaticOrder S; S.init(M, D, F.G, (int)blockIdx.x);
      pg8::EpiGate<0> E{(const bf16*)A->out, 0, WSP(float, WS_TMP), WSP(bf16, WS_MERGED)};
      pg8::gemm_phase<pg8::EpiGate<0>, pg8::StaticOrder, true, true>(F.lds + RING_OFF, g, S, E); }
    { ArgP A = argp();
      pg8::Gemm g{WSP(bf16, WS_C2), WSP(bf16, WS_WCP), M, D, CCH}; pg8::StaticOrder S; S.init(M, D, F.G, (int)blockIdx.x);
      pg8::EpiGate<1> E{(const bf16*)A->out, 1024, WSP(float, WS_TMP), WSP(bf16, WS_MERGED)};
      pg8::gemm_phase<pg8::EpiGate<1>, pg8::StaticOrder, true, true>(F.lds + RING_OFF, g, S, E); }
}
__device__ __forceinline__ void ph5(Frame& F) {
    ArgP A = argp();
    pg8::Gemm g{WSP(bf16, WS_MERGED), WSP(bf16, WS_WOUT), M, D, D}; pg8::StaticOrder S; S.init(M, D, F.G, (int)blockIdx.x);
    pg8::EpiRes E{A->in[0], A->out, WSP(bf16, WS_X1B), WSP(float, WS_SSQ1)};
    pg8::gemm_phase<pg8::EpiRes, pg8::StaticOrder, true, true>(F.lds + RING_OFF, g, S, E);
}
__device__ __forceinline__ void ph6(Frame& F) {
    ArgP A = argp();
    pg8::Gemm g{WSP(bf16, WS_X1B), WSP(bf16, WS_WCQ), M, D, D}; pg8::StaticOrder S; S.init(M, D, F.G, (int)blockIdx.x);
    pg8::EpiRmsBf16<0> E{WSP(bf16, WS_CQ), D, WSP(float, WS_SSQ1), CQSCALE, EPS};
    pg8::gemm_phase<pg8::EpiRmsBf16<0>, pg8::StaticOrder, true, true>(F.lds + RING_OFF, g, S, E);
}
__device__ __forceinline__ void ph7(Frame& F) {
    ArgP A = argp();
#pragma unroll 1
    for (int u = F.vcu; u < 256; u += F.G) cross_attn_unit(F, u, WSP(bf16, WS_CQ), WSP(bf16, WS_CKV), WSP(bf16, WS_CO));
}
__device__ __forceinline__ void ph8(Frame& F) {
    ArgP A = argp();
    pg8::Gemm g{WSP(bf16, WS_CO), WSP(bf16, WS_WCO), M, D, D}; pg8::StaticOrder S; S.init(M, D, F.G, (int)blockIdx.x);
    pg8::EpiRes E{A->out, A->out, WSP(bf16, WS_X2B), WSP(float, WS_SSQ2)};
    pg8::gemm_phase<pg8::EpiRes, pg8::StaticOrder, true, true>(F.lds + RING_OFF, g, S, E);
}
__device__ __forceinline__ void ph9(Frame& F) {
    ArgP A = argp();
    pg8::Gemm g{WSP(bf16, WS_X2B), WSP(bf16, WS_WUP), M, FF, D}; pg8::StaticOrder S; S.init(M, FF, F.G, (int)blockIdx.x);
    pg8::EpiRmsBf16<1> E{WSP(bf16, WS_H), FF, WSP(float, WS_SSQ2), 1.0f, EPS};
    pg8::gemm_phase<pg8::EpiRmsBf16<1>, pg8::StaticOrder, true, true>(F.lds + RING_OFF, g, S, E);
}
__device__ __forceinline__ void ph10(Frame& F) {
    ArgP A = argp();
    pg8::Gemm g{WSP(bf16, WS_H), WSP(bf16, WS_WDN), M, D, FF}; pg8::StaticOrder S; S.init(M, D, F.G, (int)blockIdx.x);
    pg8::EpiRes E{A->out, A->out, nullptr, WSP(float, WS_SSQ3)};
    pg8::gemm_phase<pg8::EpiRes, pg8::StaticOrder, true, true>(F.lds + RING_OFF, g, S, E);
}
__device__ __forceinline__ void ph11(Frame& F) {
    ArgP A = argp();
    const int gw = F.vcu * NWAVES + F.wave, NGW = F.G * NWAVES;
    float* out = A->out; const float* SSQ3 = WSP(float, WS_SSQ3); const float* g_final = A->in[20];
#pragma unroll 1
    for (int m = gw; m < M; m += NGW) {
        const f32x4* sp = (const f32x4*)(SSQ3 + (size_t)m * 16); const f32x4 st = (sp[0] + sp[1]) + (sp[2] + sp[3]);
        const float rstd = 1.0f / sqrtf(((st[0] + st[1]) + (st[2] + st[3])) * (1.0f / D) + EPS);
        GAS f32x4* xr = (GAS f32x4*)(out + (size_t)m * D) + F.lane; const GAS f32x4* gr = (const GAS f32x4*)g_final + F.lane;
#pragma unroll
        for (int j = 0; j < 4; ++j) { const f32x4 v = xr[64 * j]; xr[64 * j] = v * rstd * gr[64 * j]; }
    }
}

#ifndef PH_MASK
#define PH_MASK 0xFFF
#endif
__global__ void __launch_bounds__(NWAVES * 64, 2) mk_fwd(Args args) {
    extern __shared__ __attribute__((aligned(16))) unsigned char lds[];
    Frame F;
    F.lds = (LAS unsigned char*)lds;
    F.MISC = (volatile LAS unsigned*)(F.lds + MISC_OFF);
    F.tid = threadIdx.x; F.lane = F.tid & 63; F.wave = __builtin_amdgcn_readfirstlane(F.tid >> 6);
    F.G = gridDim.x; { const int bx = blockIdx.x; F.vcu = (F.G % 8 == 0) ? (bx % 8) * (F.G / 8) + bx / 8 : bx; }
    F.ctl = (gu32*)(args.ws + WS_CTL);
    for (int u = F.tid; u < (LDS_BYTES - LDSCTL_OFF) / 4; u += NWAVES * 64) ((LAS unsigned*)(F.lds + LDSCTL_OFF))[u] = 0u;
    __syncthreads();
    const int lo = args.ph_lo, hi = args.ph_hi;
    const bool multi = (hi - lo) > 1;
    XcdBarrier bar; bar.bar = (unsigned*)(F.ctl + CW_BAR); bar.x = 0; bar.st = nullptr;
    if (multi) bar = xcd_barrier_post((unsigned*)(F.ctl + CW_BAR), F.MISC + 8);
#define IN(k) (((PH_MASK >> (k)) & 1) && lo <= (k) && (k) < hi)
#define SEAM(k) do { if (lo <= (k) && (k) + 1 < hi) xcd_barrier(bar); } while (0)
    if (IN(0)) ph0(F);
    SEAM(0);
    if (IN(1)) ph1(F);
    SEAM(1);
    if (IN(2)) ph2(F);
    SEAM(2);
    if (IN(3)) ph3(F);
    SEAM(3);
    if (IN(4)) ph4(F);
    SEAM(4);
    if (IN(5)) ph5(F);
    SEAM(5);
    if (IN(6)) ph6(F);
    SEAM(6);
    if (IN(7)) ph7(F);
    SEAM(7);
    if (IN(8)) ph8(F);
    SEAM(8);
    if (IN(9)) ph9(F);
    SEAM(9);
    if (IN(10)) ph10(F);
    SEAM(10);
    if (IN(11)) ph11(F);
#undef IN
#undef SEAM
}

#ifndef MK_ONE_LAUNCH
#define MK_ONE_LAUNCH 1
#endif
constexpr int N_PHASES = 12;
extern "C" void kernel_launch(void* const* d_in, const int* in_sizes, int n_in, void* d_out, int out_size, void* d_ws, size_t ws_size, hipStream_t stream) {
    static int grid = 0;
    if (grid == 0) {
        if (n_in != 21 || out_size != M * D || ws_size < WS_END) { fprintf(stderr, "kernel_launch: unexpected shapes: n_in %d out %d ws %zu\n", n_in, out_size, ws_size); grid = -1; return; }
        int dev = 0, cus = 0, per_cu = 0;
        if (hipGetDevice(&dev) != hipSuccess || hipDeviceGetAttribute(&cus, hipDeviceAttributeMultiprocessorCount, dev) != hipSuccess) { grid = -1; return; }
        if (hipFuncSetAttribute((const void*)mk_fwd, hipFuncAttributeMaxDynamicSharedMemorySize, LDS_BYTES) != hipSuccess) { fprintf(stderr, "kernel_launch: hipFuncSetAttribute failed\n"); grid = -1; return; }
        if (hipOccupancyMaxActiveBlocksPerMultiprocessor(&per_cu, (const void*)mk_fwd, NWAVES * 64, LDS_BYTES) != hipSuccess || per_cu < 1) { fprintf(stderr, "kernel_launch: occupancy query says %d blocks per CU\n", per_cu); (void)hipGetLastError(); grid = -1; return; }
        grid = cus;
    }
    if (grid < 0) return;
    (void)hipMemsetAsync((char*)d_ws + WS_CTL, 0, CTL_ZERO_BYTES, stream);
    Args a{};
    for (int i = 0; i < 21; ++i) a.in[i] = (const float*)d_in[i];
    a.out = (float*)d_out; a.ws = (unsigned char*)d_ws;
#if MK_ONE_LAUNCH
    a.ph_lo = 0; a.ph_hi = N_PHASES;
    void* kargs[] = {&a};
    hipError_t e = hipLaunchCooperativeKernel((const void*)mk_fwd, dim3(grid), dim3(NWAVES * 64), kargs, LDS_BYTES, stream);
    if (e != hipSuccess) fprintf(stderr, "kernel_launch: cooperative launch failed: %s (grid %d)\n", hipGetErrorString(e), grid);
#else
    for (int p = 0; p < N_PHASES; ++p) { a.ph_lo = p; a.ph_hi = p + 1; hipLaunchKernelGGL(mk_fwd, dim3(grid), dim3(NWAVES * 64), LDS_BYTES, stream, a); }
#endif
}
```

```cpp
#include <hip/hip_runtime.h>
#include <cstdio>
#include <cstdint>
namespace pg8 {
#define PG8_LAS __attribute__((address_space(3)))
typedef unsigned short bf16_t;
typedef short bf16x8 __attribute__((ext_vector_type(8)));
typedef float f32x4 __attribute__((ext_vector_type(4)));
typedef unsigned u32x4 __attribute__((ext_vector_type(4)));
constexpr int BM = 256, BK = 64, HALF = 128, HTB = HALF * BK * 2  , STAGE_BYTES = 8 * HTB, NXCD = 8, WGM = 8;

__host__ __device__ __forceinline__ int lds_byte(int r, int c) { const int st = (r >> 4) * 2 + (c >> 5), rr = r & 15, cc = c & 31, ob = rr * 64 + cc * 2; return st * 1024 + (ob ^ (((ob >> 9) & 1) << 5)); }
__host__ __device__ __forceinline__ void stage_rc(int b, int& R, int& C) { const int st = b / 1024, sb = b % 1024, swz = sb ^ (((sb >> 9) & 1) << 5); R = (st >> 1) * 16 + swz / 64; C = (st & 1) * 32 + (swz % 64) / 2; }
__host__ __device__ __forceinline__ int perm32(int rho) { const int n = rho >> 4, i = rho & 15; return 8 * (i >> 2) + 4 * n + (i & 3); }

struct Unit { int pm, pn; };
struct Gemm { const bf16_t* A; const bf16_t* Bt; int M, N, K; };

struct StaticOrder {
    int nM, nN, nwg, G, c;
    __host__ __device__ void init(int M, int N, int G_, int c_) { nM = M / BM; nN = N / BM; nwg = nM * nN; G = G_; c = c_; }
    __host__ __device__ bool next(int i, Unit& u) const {
        const long L = (long)i * G + c; if (L >= nwg) return false;
        int wgid = (int)L; { const int q = nwg / NXCD, r = nwg % NXCD, xcd = wgid % NXCD, off = wgid / NXCD; wgid = (xcd < r ? xcd * (q + 1) : r * (q + 1) + (xcd - r) * q) + off; }
        const int nig = WGM * nN, gid = wgid / nig, fm = gid * WGM, gsz = (nM - fm) < WGM ? (nM - fm) : WGM;
        u.pm = fm + ((wgid % nig) % gsz); u.pn = (wgid % nig) / gsz; return true;
    }
    __device__ __forceinline__ void a_ready(const Unit&) const {}
    __device__ __forceinline__ void done(const Unit&) const {}
};

typedef float f32x2 __attribute__((ext_vector_type(2)));
typedef __bf16 bf16x2_t __attribute__((ext_vector_type(2)));
__device__ __forceinline__ unsigned cvt_pk_bf16(float lo, float hi) { const f32x2 v = {lo, hi}; const bf16x2_t b = __builtin_convertvector(v, bf16x2_t); return __builtin_bit_cast(unsigned, b); }
typedef float f32x2 __attribute__((ext_vector_type(2)));
typedef unsigned u32x2 __attribute__((ext_vector_type(2)));
__device__ __forceinline__ float sigmoidf_fast(float x) { return __builtin_amdgcn_rcpf(1.0f + __builtin_amdgcn_exp2f(-1.4426950408889634f * x)); }
__device__ __forceinline__ u32x4 pack8(const f32x4 v0, const f32x4 v1) { u32x4 w; w.x = cvt_pk_bf16(v0[0], v0[1]); w.y = cvt_pk_bf16(v0[2], v0[3]); w.z = cvt_pk_bf16(v1[0], v1[1]); w.w = cvt_pk_bf16(v1[2], v1[3]); return w; }
__device__ __forceinline__ f32x4 bf4_to_f32(const u32x2 w) { f32x4 r; r[0] = __uint_as_float(w.x << 16); r[1] = __uint_as_float(w.x & 0xffff0000u); r[2] = __uint_as_float(w.y << 16); r[3] = __uint_as_float(w.y & 0xffff0000u); return r; }

struct EpiPlainBf16 {
    static constexpr bool PERM = true, AFTER_DRAIN = false;
    bf16_t* O; int ldc;
    __device__ __forceinline__ void operator()(const f32x4 (&acc)[2][2][4][2], const Unit& u, int wr, int wc, int fr, int fq) const {
        const int row0 = u.pm * BM + wr * 64 + fr, col0 = u.pn * BM + wc * 32 + 8 * fq;
#pragma unroll
        for (int ai = 0; ai < 2; ++ai)
#pragma unroll
            for (int m = 0; m < 4; ++m) { bf16_t* rowp = O + (size_t)(row0 + ai * HALF + m * 16) * ldc + col0;
#pragma unroll
                for (int bj = 0; bj < 2; ++bj) *(u32x4*)(rowp + bj * HALF) = pack8(acc[ai][bj][m][0], acc[ai][bj][m][1]); }
    }
};

struct EpiG1 {
    static constexpr bool PERM = true, AFTER_DRAIN = false;
    bf16_t* Z; bf16_t* C; bf16_t* G; const float* cs; const float* bgate; float qscale;
    __device__ __forceinline__ void operator()(const f32x4 (&acc)[2][2][4][2], const Unit& u, int wr, int wc, int fr, int fq) const {
        const int row0 = u.pm * BM + wr * 64 + fr; const int pn = u.pn;
        if (pn < 18) {
            const bool rope = (pn < 12) && (wc == 0);
            const float sc = pn < 6 ? qscale : 1.f;
            const int col0 = pn * BM + wc * 32 + 8 * fq;
#pragma unroll
            for (int ai = 0; ai < 2; ++ai)
#pragma unroll
                for (int m = 0; m < 4; ++m) { const int row = row0 + ai * HALF + m * 16; bf16_t* rowp = Z + (size_t)row * 4608 + col0;
                    f32x4 cA = {1.f, 1.f, 1.f, 1.f}, sA = {0.f, 0.f, 0.f, 0.f};
                    if (rope) { const float* t = cs + ((size_t)(row & 8191) * 16 + 4 * fq) * 2; const f32x4 t0 = *(const f32x4*)t, t1 = *(const f32x4*)(t + 4);
                        cA = (f32x4){t0[0], t0[2], t1[0], t1[2]}; sA = (f32x4){t0[1], t0[3], t1[1], t1[3]}; }
#pragma unroll
                    for (int bj = 0; bj < 2; ++bj) { const f32x4 x1 = acc[ai][bj][m][0], x2 = acc[ai][bj][m][1];
                        const f32x4 o1 = (x1 * cA - x2 * sA) * sc, o2 = (x2 * cA + x1 * sA) * sc;
                        *(u32x4*)(rowp + bj * HALF) = pack8(o1, o2); } }
        } else if (pn < 24) {
            const int ch0 = (pn - 18) * HALF + wc * 32 + 8 * fq;
#pragma unroll
            for (int ai = 0; ai < 2; ++ai)
#pragma unroll
                for (int m = 0; m < 4; ++m) { const int row = row0 + ai * HALF + m * 16; f32x4 o[2];
#pragma unroll
                    for (int n = 0; n < 2; ++n) { const f32x4 a = acc[ai][0][m][n], b = acc[ai][1][m][n];
#pragma unroll
                        for (int j = 0; j < 4; ++j) o[n][j] = a[j] * sigmoidf_fast(b[j]); }
                    *(u32x4*)(C + (size_t)row * 768 + ch0) = pack8(o[0], o[1]); }
        } else {
            const int g0 = (pn - 24) * BM + wc * 32 + 8 * fq;
            f32x4 bv[2][2];
#pragma unroll
            for (int bj = 0; bj < 2; ++bj)
#pragma unroll
                for (int n = 0; n < 2; ++n) bv[bj][n] = *(const f32x4*)(bgate + g0 + bj * HALF + 4 * n);
#pragma unroll
            for (int ai = 0; ai < 2; ++ai)
#pragma unroll
                for (int m = 0; m < 4; ++m) { const int row = row0 + ai * HALF + m * 16; bf16_t* rowp = G + (size_t)row * 2048 + g0;
#pragma unroll
                    for (int bj = 0; bj < 2; ++bj) { f32x4 o[2];
#pragma unroll
                        for (int n = 0; n < 2; ++n) { const f32x4 v = acc[ai][bj][m][n] + bv[bj][n];
#pragma unroll
                            for (int j = 0; j < 4; ++j) o[n][j] = sigmoidf_fast(v[j]); }
                        *(u32x4*)(rowp + bj * HALF) = pack8(o[0], o[1]); } }
        }
    }
};

template <int PASS> struct EpiGate {
    static constexpr bool PERM = true, AFTER_DRAIN = false;
    const bf16_t* G; int goff; float* tmp; bf16_t* O;
    __device__ __forceinline__ void operator()(const f32x4 (&acc)[2][2][4][2], const Unit& u, int wr, int wc, int fr, int fq) const {
        const int row0 = u.pm * BM + wr * 64 + fr, col0 = u.pn * BM + wc * 32 + 8 * fq;
#pragma unroll
        for (int ai = 0; ai < 2; ++ai)
#pragma unroll
            for (int m = 0; m < 4; ++m) { const int row = row0 + ai * HALF + m * 16;
#pragma unroll
                for (int bj = 0; bj < 2; ++bj) { const int col = col0 + bj * HALF;
                    const u32x4 gw = *(const u32x4*)(G + (size_t)row * 2048 + goff + col);
                    const f32x4 g0 = bf4_to_f32((u32x2){gw.x, gw.y}), g1 = bf4_to_f32((u32x2){gw.z, gw.w});
                    float* tp = tmp + (size_t)row * 1024 + col;
                    if (PASS == 0) { *(f32x4*)tp = g0 * acc[ai][bj][m][0]; *(f32x4*)(tp + 4) = g1 * acc[ai][bj][m][1]; }
                    else { const f32x4 o0 = *(const f32x4*)tp + g0 * acc[ai][bj][m][0], o1 = *(const f32x4*)(tp + 4) + g1 * acc[ai][bj][m][1];
                        *(u32x4*)(O + (size_t)row * 1024 + col) = pack8(o0, o1); } } }
    }
};

struct EpiRes {
    static constexpr bool PERM = false, AFTER_DRAIN = false;
    const float* base; float* out; bf16_t* xb; float* ssq;
    __device__ __forceinline__ void operator()(const f32x4 (&acc)[2][2][4][2], const Unit& u, int wr, int wc, int fr, int fq) const {
        const int row0 = u.pm * BM + wr * 64 + fr, col0 = u.pn * BM + wc * 32 + 4 * fq;
#pragma unroll
        for (int ai = 0; ai < 2; ++ai)
#pragma unroll
            for (int m = 0; m < 4; ++m) { const int row = row0 + ai * HALF + m * 16; const size_t off = (size_t)row * 1024 + col0; float sq = 0.f;
#pragma unroll
                for (int bj = 0; bj < 2; ++bj)
#pragma unroll
                    for (int n = 0; n < 2; ++n) { const f32x4 o = *(const f32x4*)(base + off + bj * HALF + n * 16) + acc[ai][bj][m][n];
                        *(f32x4*)(out + off + bj * HALF + n * 16) = o; sq += (o[0] * o[0] + o[1] * o[1]) + (o[2] * o[2] + o[3] * o[3]);
                        if (xb) { u32x2 w; w.x = cvt_pk_bf16(o[0], o[1]); w.y = cvt_pk_bf16(o[2], o[3]); *(u32x2*)(xb + off + bj * HALF + n * 16) = w; } }
                sq += __shfl_xor(sq, 16); sq += __shfl_xor(sq, 32);
                if (fq == 0) ssq[(size_t)row * 16 + u.pn * 4 + wc] = sq; }
    }
};

template <int ACT> struct EpiRmsBf16 {
    static constexpr bool PERM = true, AFTER_DRAIN = false;
    bf16_t* O; int ldc; const float* ssq; float scale, eps;
    __device__ __forceinline__ void operator()(const f32x4 (&acc)[2][2][4][2], const Unit& u, int wr, int wc, int fr, int fq) const {
        const int row0 = u.pm * BM + wr * 64 + fr, col0 = u.pn * BM + wc * 32 + 8 * fq;
#pragma unroll
        for (int ai = 0; ai < 2; ++ai)
#pragma unroll
            for (int m = 0; m < 4; ++m) { const int row = row0 + ai * HALF + m * 16; const f32x4* sp = (const f32x4*)(ssq + (size_t)row * 16);
                const f32x4 s0 = sp[0], s1 = sp[1], s2 = sp[2], s3 = sp[3]; const f32x4 st = (s0 + s1) + (s2 + s3);
                const float tot = (st[0] + st[1]) + (st[2] + st[3]); const float rs = __builtin_amdgcn_rsqf(tot * (1.0f / 1024.0f) + eps) * scale;
                bf16_t* rowp = O + (size_t)row * ldc + col0;
#pragma unroll
                for (int bj = 0; bj < 2; ++bj) { f32x4 v0 = acc[ai][bj][m][0] * rs, v1 = acc[ai][bj][m][1] * rs;
                    if (ACT == 1) {
#pragma unroll
                        for (int j = 0; j < 4; ++j) { const float a = fmaxf(v0[j], 0.f), b = fmaxf(v1[j], 0.f); v0[j] = a * a; v1[j] = b * b; } }
                    *(u32x4*)(rowp + bj * HALF) = pack8(v0, v1); } }
    }
};

template <class Epi, class Sched, bool ALIGN_EPI = false, bool SP2 = false>
__device__ __forceinline__ void gemm_phase(PG8_LAS unsigned char* lds, const Gemm g, const Sched& S, const Epi& E) {
    const int tid = threadIdx.x, wid = __builtin_amdgcn_readfirstlane(tid >> 6), lane = tid & 63, wr = wid >> 2, wc = wid & 3, fr = lane & 15, fq = lane >> 4;
    const int K = g.K, nt = K / BK;
    unsigned voffA[2], voffB[2];
#pragma unroll
    for (int i = 0; i < 2; ++i) { int R, C; stage_rc(tid * 16 + i * 8192, R, C); const int Rb = Epi::PERM ? ((R & ~31) + perm32(R & 31)) : R;
        voffA[i] = (unsigned)(R * K + C) * 2u; voffB[i] = (unsigned)(Rb * K + C) * 2u; }
    const size_t kstep = (size_t)(BK * 2);
    const size_t hstep = (size_t)HALF * K * 2;
    const size_t tstep = 2 * hstep;
    const unsigned ldsw = (unsigned)wid * 1024u;
    const int aoff = lds_byte(wr * 64 + fr, fq * 8), boff = lds_byte(wc * 32 + fr, fq * 8);
#define PG8_SA(b, h) (((b) * 2 + (h)) * HTB)
#define PG8_SB(b, h) ((4 + (b) * 2 + (h)) * HTB)
#define PG8_STAGE(bufoff, gbase, voff) do { _Pragma("unroll") for (int _i = 0; _i < 2; ++_i) \
        __builtin_amdgcn_global_load_lds((const unsigned*)((const char*)(gbase) + (voff)[_i]), (PG8_LAS unsigned*)(lds + (bufoff) + ldsw + _i * 8192), 16, 0, 0); } while (0)
#define PG8_LDA(dst, b, h) do { _Pragma("unroll") for (int m = 0; m < 4; ++m) _Pragma("unroll") for (int k = 0; k < 2; ++k) dst[m][k] = *(const PG8_LAS bf16x8*)(lds + PG8_SA(b, h) + aoff + m * 2048 + k * 1024); } while (0)
#define PG8_LDB(dst, b, h) do { _Pragma("unroll") for (int n = 0; n < 2; ++n) _Pragma("unroll") for (int k = 0; k < 2; ++k) dst[n][k] = *(const PG8_LAS bf16x8*)(lds + PG8_SB(b, h) + boff + n * 2048 + k * 1024); } while (0)
#define PG8_MMA(ai, bj, At, Bt) do { __builtin_amdgcn_s_setprio(1); _Pragma("unroll") for (int m = 0; m < 4; ++m) _Pragma("unroll") for (int n = 0; n < 2; ++n) _Pragma("unroll") for (int k = 0; k < 2; ++k) \
        acc[ai][bj][m][n] = __builtin_amdgcn_mfma_f32_16x16x32_bf16(Bt[n][k], At[m][k], acc[ai][bj][m][n], 0, 0, 0); __builtin_amdgcn_s_setprio(0); } while (0)
#define PG8_WAIT_V(n) asm volatile("s_waitcnt vmcnt(" #n ")" ::: "memory")
#define PG8_WAIT_L(n) asm volatile("s_waitcnt lgkmcnt(" #n ")" ::: "memory")
#define PG8_BAR __builtin_amdgcn_s_barrier()
#define PG8_SCHED __builtin_amdgcn_sched_barrier(0)
    Unit cur, nxt; int ui = 0;
    if (!S.next(0, cur)) return;
    f32x4 acc[2][2][4][2];
#pragma unroll
    for (int a = 0; a < 2; ++a)
#pragma unroll
        for (int b = 0; b < 2; ++b)
#pragma unroll
            for (int m = 0; m < 4; ++m)
#pragma unroll
                for (int n = 0; n < 2; ++n) acc[a][b][m][n] = (f32x4){0.f, 0.f, 0.f, 0.f};
    bf16x8 At[4][2], B0[2][2], B1[2][2];
    const char* cA = (const char*)g.A + (size_t)cur.pm * tstep; const char* cB = (const char*)g.Bt + (size_t)cur.pn * tstep;
    S.a_ready(cur);
    if constexpr (SP2) {
        PG8_STAGE(PG8_SB(0, 0), cB, voffB); PG8_STAGE(PG8_SB(0, 1), cB + hstep, voffB); PG8_STAGE(PG8_SA(0, 0), cA, voffA); PG8_STAGE(PG8_SA(0, 1), cA + hstep, voffA);
        if (wr == 1) PG8_BAR;
        PG8_WAIT_V(2); PG8_BAR;
        PG8_STAGE(PG8_SB(1, 0), cB + kstep, voffB); PG8_STAGE(PG8_SA(1, 0), cA + kstep, voffA); PG8_STAGE(PG8_SB(1, 1), cB + hstep + kstep, voffB);
        PG8_WAIT_V(6); PG8_BAR;
    } else {
        PG8_STAGE(PG8_SB(0, 0), cB, voffB); PG8_STAGE(PG8_SA(0, 0), cA, voffA); PG8_STAGE(PG8_SB(0, 1), cB + hstep, voffB); PG8_STAGE(PG8_SA(0, 1), cA + hstep, voffA);
        if (wr == 1) PG8_BAR;
        PG8_WAIT_V(4); PG8_BAR;
        PG8_STAGE(PG8_SB(1, 0), cB + kstep, voffB); PG8_STAGE(PG8_SA(1, 0), cA + kstep, voffA); PG8_STAGE(PG8_SB(1, 1), cB + hstep + kstep, voffB);
        PG8_WAIT_V(6); PG8_BAR;
    }
    for (;;) {
        const bool has_next = S.next(ui + 1, nxt);
        const char* nA = has_next ? (const char*)g.A + (size_t)nxt.pm * tstep : cA; const char* nB = has_next ? (const char*)g.Bt + (size_t)nxt.pn * tstep : cB;
        for (int t = 0; t < nt; t += 2) {
            const bool last = (t == nt - 2);
            const char* a1 = cA + (size_t)(t + 1) * kstep;
            const char* a2 = last ? nA : cA + (size_t)(t + 2) * kstep; const char* b2 = last ? nB : cB + (size_t)(t + 2) * kstep;
            const char* a3 = a2 + kstep; const char* b3 = b2 + kstep;
            if (last && has_next) S.a_ready(nxt);
            if constexpr (SP2) {
            PG8_LDB(B0, 0, 0); PG8_LDB(B1, 0, 1); PG8_SCHED; PG8_LDA(At, 0, 0); PG8_STAGE(PG8_SA(1, 1), a1 + hstep, voffA);
            PG8_WAIT_V(8); PG8_WAIT_L(0); PG8_BAR; PG8_MMA(0, 0, At, B0); PG8_MMA(0, 1, At, B1); PG8_BAR; PG8_SCHED;
            PG8_LDA(At, 0, 1); PG8_STAGE(PG8_SB(0, 0), b2, voffB); PG8_STAGE(PG8_SB(0, 1), b2 + hstep, voffB); PG8_STAGE(PG8_SA(0, 0), a2, voffA);
            PG8_WAIT_V(8); PG8_WAIT_L(0); PG8_BAR; PG8_MMA(1, 0, At, B0); PG8_MMA(1, 1, At, B1); PG8_BAR; PG8_SCHED;
            PG8_LDB(B0, 1, 0); PG8_LDB(B1, 1, 1); PG8_SCHED; PG8_LDA(At, 1, 0); PG8_STAGE(PG8_SA(0, 1), a2 + hstep, voffA);
            PG8_WAIT_V(8); PG8_WAIT_L(0); PG8_BAR; PG8_MMA(0, 0, At, B0); PG8_MMA(0, 1, At, B1); PG8_BAR; PG8_SCHED;
            PG8_LDA(At, 1, 1); PG8_STAGE(PG8_SB(1, 0), b3, voffB); PG8_STAGE(PG8_SB(1, 1), b3 + hstep, voffB); PG8_STAGE(PG8_SA(1, 0), a3, voffA);
            PG8_WAIT_V(8); PG8_WAIT_L(0); PG8_BAR; PG8_MMA(1, 0, At, B0); PG8_MMA(1, 1, At, B1); PG8_BAR; PG8_SCHED;
            } else {
            PG8_LDB(B0, 0, 0); PG8_SCHED; PG8_LDA(At, 0, 0); PG8_STAGE(PG8_SA(1, 1), a1 + hstep, voffA);
            PG8_WAIT_L(8); PG8_BAR; PG8_WAIT_L(0); PG8_MMA(0, 0, At, B0); PG8_BAR; PG8_SCHED;
            PG8_LDB(B1, 0, 1); PG8_STAGE(PG8_SB(0, 0), b2, voffB);
            PG8_BAR; PG8_WAIT_L(0); PG8_MMA(0, 1, At, B1); PG8_BAR;
            PG8_LDA(At, 0, 1); PG8_STAGE(PG8_SA(0, 0), a2, voffA);
            PG8_BAR; PG8_WAIT_L(0); PG8_MMA(1, 0, At, B0); PG8_BAR; PG8_SCHED;
            PG8_STAGE(PG8_SB(0, 1), b2 + hstep, voffB);
            PG8_WAIT_V(6); PG8_BAR; PG8_MMA(1, 1, At, B1); PG8_BAR;
            PG8_LDB(B0, 1, 0); PG8_SCHED; PG8_LDA(At, 1, 0); PG8_STAGE(PG8_SA(0, 1), a2 + hstep, voffA);
            PG8_WAIT_L(8); PG8_BAR; PG8_WAIT_L(0); PG8_MMA(0, 0, At, B0); PG8_BAR; PG8_SCHED;
            PG8_LDB(B1, 1, 1); PG8_STAGE(PG8_SB(1, 0), b3, voffB);
            PG8_BAR; PG8_WAIT_L(0); PG8_MMA(0, 1, At, B1); PG8_BAR;
            PG8_LDA(At, 1, 1); PG8_STAGE(PG8_SA(1, 0), a3, voffA);
            PG8_BAR; PG8_WAIT_L(0); PG8_MMA(1, 0, At, B0); PG8_BAR; PG8_SCHED;
            PG8_STAGE(PG8_SB(1, 1), b3 + hstep, voffB);
            PG8_WAIT_V(6); PG8_BAR; PG8_MMA(1, 1, At, B1); PG8_BAR;
            }
        }
        if constexpr (ALIGN_EPI) { if (wr == 0) PG8_BAR; }
        if constexpr (!Epi::AFTER_DRAIN) { E(acc, cur, wr, wc, fr, fq); S.done(cur); }
        if (!has_next) break;
#pragma unroll
        for (int a = 0; a < 2; ++a)
#pragma unroll
            for (int b = 0; b < 2; ++b)
#pragma unroll
                for (int m = 0; m < 4; ++m)
#pragma unroll
                    for (int n = 0; n < 2; ++n) acc[a][b][m][n] = (f32x4){0.f, 0.f, 0.f, 0.f};
        cur = nxt; cA = nA; cB = nB; ++ui;
        if constexpr (ALIGN_EPI) { if (wr == 1) PG8_BAR; }
    }
    PG8_WAIT_V(0);
    if constexpr (!ALIGN_EPI) { if (wr == 0) PG8_BAR; }
    PG8_BAR;
    if constexpr (Epi::AFTER_DRAIN) { E.fused(acc, cur, wr, wc, fr, fq, lds, wid, lane); S.done(cur); }
#undef PG8_SA
#undef PG8_SB
#undef PG8_STAGE
#undef PG8_LDA
#undef PG8_LDB
#undef PG8_MMA
#undef PG8_WAIT_V
#undef PG8_WAIT_L
#undef PG8_BAR
#undef PG8_SCHED
}
}

#define GAS __attribute__((address_space(1)))
#define LAS __attribute__((address_space(3)))
typedef unsigned short bf16;
typedef unsigned v4u __attribute__((ext_vector_type(4)));
typedef float f32x4 __attribute__((ext_vector_type(4)));
typedef short bf16x8 __attribute__((ext_vector_type(8)));
typedef GAS unsigned gu32;
typedef GAS unsigned long long gu64;
#define RLX_AGENT __ATOMIC_RELAXED, __HIP_MEMORY_SCOPE_AGENT
#define LDS_WAIT() asm volatile("s_waitcnt lgkmcnt(0)" ::: "memory")
#define VM_WAIT() asm volatile("s_waitcnt vmcnt(0)" ::: "memory")
__device__ __forceinline__ unsigned long long rt() { return __builtin_amdgcn_s_memrealtime(); }
__device__ __forceinline__ unsigned f2bf(float f) { unsigned u = __builtin_bit_cast(unsigned, f); return (u + 0x7fffu + ((u >> 16) & 1u)) >> 16; }
__device__ __forceinline__ unsigned pk2(float lo, float hi) { return f2bf(lo) | (f2bf(hi) << 16); }

#define XB_TMO      128
#define XB_XCNT(j)  (256  + 64 * (j))
#define XB_XSUB(j)  (1280 + 64 * (j))
#define XB_XGEN(j)  (2304 + 64 * (j))
#define XB_TOP      3328
#define XB_TOPGEN   3392
#define XCD_BAR_WORDS 3456
#define XB_SPIN_CAP (1u << 18)

__device__ __forceinline__ unsigned xb_ld(unsigned* p)              { return __hip_atomic_load(p, __ATOMIC_RELAXED, __HIP_MEMORY_SCOPE_AGENT); }
__device__ __forceinline__ unsigned xb_add(unsigned* p, unsigned v) { return __hip_atomic_fetch_add(p, v, __ATOMIC_RELAXED, __HIP_MEMORY_SCOPE_AGENT); }
__device__ __forceinline__ unsigned xb_xcc_id() { return (unsigned)__builtin_amdgcn_s_getreg((3 << 11) | 20) & 0xFu; }
#define XB_SPIN(cond, bar) do { unsigned _sp = 0; while (cond) { __builtin_amdgcn_s_sleep(1); \
    if ((++_sp & 255u) == 0u) { if (xb_ld(&(bar)[XB_TMO])) break; if (_sp > XB_SPIN_CAP) { atomicAdd(&(bar)[XB_TMO], 1u); break; } } } } while (0)

struct XcdBarrier {
    unsigned* bar; unsigned x;
    volatile LAS unsigned* st;
};

__device__ __forceinline__ XcdBarrier xcd_barrier_post(unsigned* bar, volatile LAS unsigned* st) {
    XcdBarrier b; b.bar = bar; b.x = xb_xcc_id(); b.st = st;
    if (threadIdx.x == 0) (void)xb_add(&bar[XB_XCNT(b.x)], 1u);
    return b;
}
__device__ __forceinline__ void xcd_barrier_complete(unsigned* bar, unsigned x, unsigned& nloc, unsigned& nx) {
    const unsigned G = gridDim.x * gridDim.y * gridDim.z;
    unsigned sum, cnt, mine, sp = 0u;
    for (;;) {
        sum = 0u; cnt = 0u; mine = 0u;
#pragma unroll
        for (unsigned j = 0; j < 16; ++j) { const unsigned c = xb_ld(&bar[XB_XCNT(j)]); sum += c; cnt += (c > 0u) ? 1u : 0u; mine = (j == x) ? c : mine; }
        if (sum == G) break;
        __builtin_amdgcn_s_sleep(1);
        if ((++sp & 255u) == 0u) { if (xb_ld(&bar[XB_TMO])) break; if (sp > XB_SPIN_CAP) { atomicAdd(&bar[XB_TMO], 1u); break; } }
    }
    nloc = mine > 0u ? mine : 1u; nx = cnt > 0u ? cnt : 1u;
}

__device__ __forceinline__ void xcd_barrier(const XcdBarrier& b) {
    asm volatile("s_waitcnt vmcnt(0)" ::: "memory");
    __syncthreads();
    if (threadIdx.x == 0) {
        unsigned* bar = b.bar;
        __builtin_amdgcn_s_waitcnt(0);
        unsigned nloc = b.st[0], nx = b.st[1];
        if (nloc == 0u) { xcd_barrier_complete(bar, b.x, nloc, nx); b.st[0] = nloc; b.st[1] = nx; }
        const unsigned old = xb_add(&bar[XB_XSUB(b.x)], 1u);
        const unsigned gen = old / nloc;
        if (old + 1u == (gen + 1u) * nloc) {
            __builtin_amdgcn_fence(__ATOMIC_RELEASE, "agent");
            asm volatile("s_waitcnt vmcnt(0)" ::: "memory");
            const unsigned og = xb_add(&bar[XB_TOP], 1u);
            const unsigned tg = og / nx;
            if (og + 1u == (tg + 1u) * nx) xb_add(&bar[XB_TOPGEN], 1u);
            else XB_SPIN(xb_ld(&bar[XB_TOPGEN]) == tg, bar);
            __builtin_amdgcn_fence(__ATOMIC_ACQUIRE, "agent");
            xb_add(&bar[XB_XGEN(b.x)], 1u);
            asm volatile("s_waitcnt vmcnt(0)" ::: "memory");
        } else {
            XB_SPIN(xb_ld(&bar[XB_XGEN(b.x)]) == gen, bar);
            __builtin_amdgcn_fence(__ATOMIC_ACQUIRE, "agent");
            asm volatile("s_waitcnt vmcnt(0)" ::: "memory");
        }
    }
    __syncthreads();
}


constexpr int BATCH = 2, SEQ = 8192, D = 1024, M = BATCH * SEQ;
constexpr int NMEM = 256, MROWS = BATCH * NMEM;
constexpr int NIN = 8192, ZW = 4608, CCH = 768, GW = 2048, AOUT = 512, FF = 4096, CONVK = 31;
constexpr float EPS = 1e-6f;
constexpr float LOG2E = 1.4426950408889634f;
constexpr float QSCALE = 0.08838834764831845f * LOG2E;
constexpr float CQSCALE = 0.0625f * LOG2E;
constexpr int NWAVES = 8;

constexpr size_t MiB = 1u << 20;
constexpr size_t WS_CTL = 0, CTL_ZERO_BYTES = 64 * 1024;
constexpr size_t WS_ROPE = 1 * MiB;
constexpr size_t WS_SSQ1 = 2 * MiB, WS_SSQ2 = 3 * MiB, WS_SSQ3 = 4 * MiB;
constexpr size_t WS_LSE = 5 * MiB;
constexpr size_t WS_MN = 6 * MiB;
constexpr size_t WS_CKV = 7 * MiB;
constexpr size_t WS_WAP = 9 * MiB, WS_WCP = 10 * MiB, WS_WOUT = 12 * MiB, WS_WCQ = 14 * MiB, WS_WCO = 16 * MiB, WS_WUP = 18 * MiB, WS_WDN = 26 * MiB;
constexpr size_t WS_WCKV = 34 * MiB, WS_WIN = 38 * MiB, WS_XN = 54 * MiB;
constexpr size_t WS_OG = 38 * MiB;
constexpr size_t WS_Z = 86 * MiB;
constexpr size_t WS_C = 230 * MiB;
constexpr size_t WS_ATTN = 86 * MiB, WS_C2 = 102 * MiB;
constexpr size_t WS_MERGED = 126 * MiB, WS_TMP = 158 * MiB;
constexpr size_t WS_X1B = 38 * MiB, WS_CQ = 70 * MiB, WS_CO = 102 * MiB, WS_X2B = 38 * MiB, WS_H = 86 * MiB;
constexpr size_t WS_END = 256 * MiB;
static_assert(WS_C + (size_t)M * CCH * 2 <= WS_END && WS_H + (size_t)M * FF * 2 <= WS_END && WS_TMP + (size_t)M * D * 4 <= WS_C, "ws map");
constexpr int CW_BAR = 4096;

constexpr int RING_OFF = 0, RING_BYTES = 131072;
constexpr int LDSCTL_OFF = RING_BYTES, MISC_OFF = LDSCTL_OFF + 320;
constexpr int LDS_BYTES = 147456;

struct Frame {
    LAS unsigned char* lds;
    volatile LAS unsigned* MISC;
    gu32* ctl;
    int tid, lane, wave;
    int vcu, G;
};

__device__ __forceinline__ float wave_sum(float v) {
#pragma unroll
    for (int o = 1; o < 64; o <<= 1) v += __shfl_xor(v, o);
    return v;
}

__device__ __forceinline__ int win_dst(int n) {
    if (n < 3072) { const int d = n & 127; if (d < 32) return (n & ~127) + 8 * ((d & 15) >> 2) + 4 * (d >> 4) + (d & 3); return n; }
    if (n < 4608) return n;
    if (n < 5376) { const int ch = n - 4608; return 4608 + 256 * (ch >> 7) + (ch & 127); }
    if (n < 6144) { const int ch = n - 5376; return 4608 + 256 * (ch >> 7) + 128 + (ch & 127); }
    return n;
}
template <int MODE>
__device__ __forceinline__ void p0_transpose_item(const float* W, int K, int N, bf16* WT, const float* sc, LAS float* scr, int item, int lane) {
    const int nblk = N / 32, kb = item / nblk, nb = item % nblk, k0 = 64 * kb, n0 = 32 * nb;
#pragma unroll 8
    for (int i = 0; i < 32; ++i) { const int kk = 2 * i + (lane >> 5); float v = W[(size_t)(k0 + kk) * N + n0 + (lane & 31)]; if (sc) v *= sc[k0 + kk]; scr[kk * 33 + (lane & 31)] = v; }
    LDS_WAIT(); asm volatile("" ::: "memory");
    const int c = lane & 7;
#pragma unroll
    for (int j = 0; j < 4; ++j) { const int n = (lane >> 3) + 8 * j; const LAS float* s = scr + (8 * c) * 33 + n;
        v4u o; o.x = pk2(s[0 * 33], s[1 * 33]); o.y = pk2(s[2 * 33], s[3 * 33]); o.z = pk2(s[4 * 33], s[5 * 33]); o.w = pk2(s[6 * 33], s[7 * 33]);
        const int rowd = MODE == 1 ? win_dst(n0 + n) : (n0 + n);
        *(GAS v4u*)(WT + (size_t)rowd * K + k0 + 8 * c) = o; }
    LDS_WAIT(); asm volatile("" ::: "memory");
}
__device__ __forceinline__ void rms_row_to_bf16(int lane, const float* xrow, const float* g, bf16* orow) {
    const GAS f32x4* xr = (const GAS f32x4*)xrow + lane; const GAS f32x4* gr = (const GAS f32x4*)g + lane;
    f32x4 v[4]; float s = 0.f;
#pragma unroll
    for (int j = 0; j < 4; ++j) { v[j] = xr[64 * j]; s += (v[j].x * v[j].x + v[j].y * v[j].y) + (v[j].z * v[j].z + v[j].w * v[j].w); }
    const float rstd = 1.0f / sqrtf(wave_sum(s) * (1.f / D) + EPS);
    GAS unsigned long long* o8 = (GAS unsigned long long*)orow + lane;
#pragma unroll
    for (int j = 0; j < 4; ++j) { const f32x4 gg = gr[64 * j];
        o8[64 * j] = (unsigned long long)pk2(v[j].x * rstd * gg.x, v[j].y * rstd * gg.y) | ((unsigned long long)pk2(v[j].z * rstd * gg.z, v[j].w * rstd * gg.w) << 32); }
}
__device__ const float ROPE_INV_FREQ[16] = {1.0f, 0.44036659598350525f, 0.1939227432012558f, 0.08539710193872452f, 0.03760603070259094f, 0.01656043902039528f, 0.007292664609849453f, 0.0032114458736032248f,
    0.0014142135623842478f, 0.000622772378847003f, 0.00027424818836152554f, 0.00012076973507646471f, 5.318296098266728e-05f, 2.34199997066753e-05f, 1.0313386155758053e-05f, 4.541670477919979e-06f};
__device__ __forceinline__ void rope_entry(int idx, float* cs) {
    const int i = idx & 15, pos = idx >> 4;
    const float ang = (float)pos * ROPE_INV_FREQ[i];
    const double rev4 = (double)ang * 0.63661977236758134308;
    const double q = __builtin_rint(rev4); const double y = (rev4 - q) * 1.57079632679489661923; const double y2 = y * y;
    double sn = y * (1.0 + y2 * (-1.0 / 6 + y2 * (1.0 / 120 + y2 * (-1.0 / 5040 + y2 * (1.0 / 362880 + y2 * (-1.0 / 39916800))))));
    double cn = 1.0 + y2 * (-0.5 + y2 * (1.0 / 24 + y2 * (-1.0 / 720 + y2 * (1.0 / 40320 + y2 * (-1.0 / 3628800 + y2 * (1.0 / 479001600))))));
    const int qi = ((int)(long long)q) & 3;
    double c, s;
    if (qi == 0) { c = cn; s = sn; } else if (qi == 1) { c = -sn; s = cn; } else if (qi == 2) { c = -cn; s = -sn; } else { c = sn; s = -cn; }
    cs[2 * idx] = (float)c; cs[2 * idx + 1] = (float)s;
}

typedef float f32x16 __attribute__((ext_vector_type(16)));
typedef short s16x4 __attribute__((ext_vector_type(4)));
typedef short v4i16_t __attribute__((ext_vector_type(4)));
__device__ __forceinline__ unsigned offb(unsigned row, unsigned ch) { return 256u * row + 16u * (ch ^ (((row & 3) << 2) | ((row >> 2) & 3))); }
__device__ __forceinline__ s16x4 vtr(LAS const unsigned char* p) { return __builtin_bit_cast(s16x4, __builtin_amdgcn_ds_read_tr16_b64_v4i16((LAS v4i16_t*)p)); }
__device__ __forceinline__ unsigned cvtpk(float lo, float hi) { return pg8::cvt_pk_bf16(lo, hi); }
__device__ __forceinline__ unsigned tr_addr(int lane, unsigned rowbase, unsigned c, unsigned t) {
    const unsigned h = lane >> 5, blk = (lane >> 4) & 1, q = (lane & 15) >> 2, p = lane & 3;
    return offb(rowbase + 8 * t + 4 * h + q, 4 * c + 2 * blk + (p >> 1)) + 8 * (p & 1);
}

template <int NC>
__device__ __forceinline__ void softmax_pv(f32x16& s, float& m_run, float& l_run, f32x16 (&oT)[NC], LAS const unsigned char* vimg, unsigned rowbase, int lane) {
    float tm = s[0];
#pragma unroll
    for (int i = 1; i < 16; ++i) tm = fmaxf(tm, s[i]);
    tm = fmaxf(tm, __shfl_xor(tm, 32));
    const float mn = fmaxf(m_run, tm);
    const float alpha = __builtin_amdgcn_exp2f(m_run - mn);
    float rs = 0.f;
#pragma unroll
    for (int i = 0; i < 16; ++i) { s[i] = __builtin_amdgcn_exp2f(s[i] - mn); rs += s[i]; }
    rs += __shfl_xor(rs, 32);
    l_run = l_run * alpha + rs; m_run = mn;
#pragma unroll
    for (int c = 0; c < NC; ++c)
#pragma unroll
        for (int i = 0; i < 16; ++i) oT[c][i] *= alpha;
    bf16x8 pf[2];
#pragma unroll
    for (int ks = 0; ks < 2; ++ks) { v4u w; w.x = cvtpk(s[8 * ks + 0], s[8 * ks + 1]); w.y = cvtpk(s[8 * ks + 2], s[8 * ks + 3]); w.z = cvtpk(s[8 * ks + 4], s[8 * ks + 5]); w.w = cvtpk(s[8 * ks + 6], s[8 * ks + 7]);
        pf[ks] = __builtin_bit_cast(bf16x8, w); }
#pragma unroll
    for (int c = 0; c < NC; ++c)
#pragma unroll
        for (int ks = 0; ks < 2; ++ks) {
            LAS const unsigned char* img = vimg + (c >> 2) * 65536;
            const s16x4 lo = vtr(img + tr_addr(lane, rowbase + 16 * ks, c & 3, 0)), hi = vtr(img + tr_addr(lane, rowbase + 16 * ks, c & 3, 1));
            const bf16x8 vf = (bf16x8){lo[0], lo[1], lo[2], lo[3], hi[0], hi[1], hi[2], hi[3]};
            oT[c] = __builtin_amdgcn_mfma_f32_32x32x16_bf16(vf, pf[ks], oT[c], 0, 0, 0);
        }
}

struct DilUnit { int b, g, h, r, m0, dil, hd; };
__device__ __forceinline__ DilUnit dil_decode(int unit) {
    DilUnit u; int idx = unit; const int n2r = idx & 31; idx >>= 5; u.h = idx & 3; idx >>= 2; u.g = idx % 3; u.b = idx / 3;
    const int dsh = 2 * u.g; u.dil = 1 << dsh; const int nb2 = (SEQ >> dsh) >> 8;
    u.r = n2r / nb2; u.m0 = 256 * (n2r % nb2); u.hd = u.g * 4 + u.h; return u;
}
__device__ __forceinline__ void dil_tile_load(v4u (&vv)[12], int tid, const bf16* Z, const DilUnit& u, int col) {
    const bf16* Zb = Z + (size_t)u.b * SEQ * ZW + col;
#pragma unroll
    for (int k = 0; k < 12; ++k) { const int i = tid + k * (NWAVES * 64); const int row = i >> 4, ch = i & 15; int mk = u.m0 - 128 + row; mk = mk < 0 ? 0 : mk;
        vv[k] = *(const GAS v4u*)(Zb + (unsigned)((mk * u.dil + u.r) * ZW + ch * 8)); }
}
__device__ __forceinline__ void dil_tile_store(LAS unsigned char* img, const v4u (&vv)[12], int tid) {
    const unsigned l0 = offb((unsigned)(tid >> 4), (unsigned)(tid & 15));
#pragma unroll
    for (int k = 0; k < 12; ++k) *(LAS v4u*)(img + l0 + k * 8192) = vv[k];
}
__device__ __forceinline__ void dil_attn_phase(Frame& F, const bf16* Z, bf16* OG, float* LSE) {
    const int lane = F.lane, w = F.wave, ql = lane & 31, hi = lane >> 5;
    LAS unsigned char* img = F.lds + RING_OFF;
    int unit = F.vcu;
    if (unit >= 768) return;
    unsigned ka[8], va[4][2];
#pragma unroll
    for (int ks = 0; ks < 8; ++ks) ka[ks] = offb(32 * w + ql, 2 * ks + hi);
#pragma unroll
    for (int c = 0; c < 4; ++c) { va[c][0] = tr_addr(lane, 32 * w, c, 0); va[c][1] = tr_addr(lane, 32 * w, c, 1); }
#pragma unroll 1
    for (; unit < 768; unit += F.G) {
        const DilUnit u = dil_decode(unit);
        int tid = F.tid; asm volatile("" : "+v"(tid));
        { v4u kk[12]; dil_tile_load(kk, tid, Z, u, 1536 + u.hd * 128); dil_tile_store(img, kk, tid); }
        const int mq = u.m0 + 32 * w + ql;
        const size_t orow = (size_t)u.b * SEQ + (size_t)(mq * u.dil + u.r);
        const bf16* qrow = Z + orow * ZW + u.hd * 128 + 8 * hi;
        bf16x8 qf[8];
#pragma unroll
        for (int ks = 0; ks < 8; ++ks) qf[ks] = *(const GAS bf16x8*)(qrow + 16 * ks);
        __syncthreads();
        f32x16 s[5];
#pragma unroll
        for (int t = 0; t < 5; ++t) {
            const int mk0 = u.m0 + 32 * w - 128 + 32 * t;
            __builtin_amdgcn_sched_barrier(0);
#pragma unroll
            for (int i = 0; i < 16; ++i) s[t][i] = 0.f;
            if (mk0 >= 0) {
                bf16x8 kf[8];
#pragma unroll
                for (int ks = 0; ks < 8; ++ks) kf[ks] = *(const LAS bf16x8*)(img + ka[ks] + t * 8192);
#pragma unroll
                for (int ks = 0; ks < 8; ++ks) s[t] = __builtin_amdgcn_mfma_f32_32x32x16_bf16(kf[ks], qf[ks], s[t], 0, 0, 0);
                if (t == 0) {
#pragma unroll
                    for (int i = 0; i < 16; ++i) { const int ko = (i & 3) + 8 * (i >> 2) + 4 * hi; if (ko < ql) s[t][i] = -1e30f; }
                } else if (t == 4) {
#pragma unroll
                    for (int i = 0; i < 16; ++i) { const int ko = (i & 3) + 8 * (i >> 2) + 4 * hi; if (ko > ql) s[t][i] = -1e30f; }
                }
            } else {
#pragma unroll
                for (int i = 0; i < 16; ++i) s[t][i] = -1e30f;
            }
        }
        __builtin_amdgcn_sched_barrier(0);
        v4u vv[12];
        dil_tile_load(vv, tid, Z, u, 3072 + u.hd * 128);
        __builtin_amdgcn_sched_barrier(0);
        float mx = s[0][0];
#pragma unroll
        for (int t = 0; t < 5; ++t)
#pragma unroll
            for (int i = 0; i < 16; ++i) mx = fmaxf(mx, s[t][i]);
        mx = fmaxf(mx, __shfl_xor(mx, 32));
        float l = 0.f; bf16x8 pf[5][2];
#pragma unroll
        for (int t = 0; t < 5; ++t) {
#pragma unroll
            for (int i = 0; i < 16; ++i) { s[t][i] = __builtin_amdgcn_exp2f(s[t][i] - mx); l += s[t][i]; }
#pragma unroll
            for (int ks = 0; ks < 2; ++ks) { v4u pw; pw.x = cvtpk(s[t][8 * ks + 0], s[t][8 * ks + 1]); pw.y = cvtpk(s[t][8 * ks + 2], s[t][8 * ks + 3]); pw.z = cvtpk(s[t][8 * ks + 4], s[t][8 * ks + 5]); pw.w = cvtpk(s[t][8 * ks + 6], s[t][8 * ks + 7]);
                pf[t][ks] = __builtin_bit_cast(bf16x8, pw); }
        }
        l += __shfl_xor(l, 32);
        __syncthreads();
        dil_tile_store(img, vv, tid);
        __syncthreads();
        f32x16 oT[4];
#pragma unroll
        for (int c = 0; c < 4; ++c)
#pragma unroll
            for (int i = 0; i < 16; ++i) oT[c][i] = 0.f;
#pragma unroll
        for (int t = 0; t < 5; ++t) {
            const int mk0 = u.m0 + 32 * w - 128 + 32 * t;
            __builtin_amdgcn_sched_barrier(0);
            if (mk0 >= 0) {
#pragma unroll
                for (int c = 0; c < 4; ++c)
#pragma unroll
                    for (int ks = 0; ks < 2; ++ks) {
                        const s16x4 lo = vtr(img + va[c][0] + (32 * t + 16 * ks) * 256), hh = vtr(img + va[c][1] + (32 * t + 16 * ks) * 256);
                        const bf16x8 vf = (bf16x8){lo[0], lo[1], lo[2], lo[3], hh[0], hh[1], hh[2], hh[3]};
                        oT[c] = __builtin_amdgcn_mfma_f32_32x32x16_bf16(vf, pf[t][ks], oT[c], 0, 0, 0);
                    }
            }
        }
        const float inv = 1.0f / l;
        bf16* op = OG + ((size_t)u.g * M + orow) * AOUT + u.h * 128 + 4 * hi;
#pragma unroll
        for (int c = 0; c < 4; ++c)
#pragma unroll
            for (int i4 = 0; i4 < 4; ++i4) { pg8::u32x2 wv; wv.x = cvtpk(oT[c][4 * i4] * inv, oT[c][4 * i4 + 1] * inv); wv.y = cvtpk(oT[c][4 * i4 + 2] * inv, oT[c][4 * i4 + 3] * inv);
                *(GAS pg8::u32x2*)(op + 32 * c + 8 * i4) = wv; }
        if (hi == 0) LSE[((size_t)u.g * M + orow) * 4 + u.h] = mx + __builtin_amdgcn_logf(l);
        __syncthreads();
    }
}

constexpr int CV_T = 16, CV_ROWS = CV_T + 30, CV_OUT_OFF = 73728;
__device__ __forceinline__ void conv_unit(Frame& F, int unit, const bf16* C, const float* cw, const float* cb, const float* lg, const float* lb, bf16* C2) {
    const int b = unit >> 9, t0 = (unit & 511) * CV_T;
    const bf16* Cb = C + (size_t)b * SEQ * CCH;
    LAS unsigned char* st = F.lds + RING_OFF;
    { v4u vv[9];
      const bf16* tile0 = Cb + (ptrdiff_t)(t0 - 30) * CCH;
#pragma unroll
      for (int k = 0; k < 9; ++k) { const int i = F.tid + k * (NWAVES * 64); vv[k] = (v4u){0u, 0u, 0u, 0u};
          if (i < CV_ROWS * 96 && (t0 - 30) * 96 + i >= 0) vv[k] = *(const GAS v4u*)(tile0 + (ptrdiff_t)i * 8); }
#pragma unroll
      for (int k = 0; k < 9; ++k) { const int i = F.tid + k * (NWAVES * 64); if (i < CV_ROWS * 96) *(LAS v4u*)(st + i * 16) = vv[k]; } }
    __syncthreads();
    const int cp = F.tid;
    if (cp < 384) {
        pg8::f32x2 wt[CONVK];
#pragma unroll
        for (int j = 0; j < CONVK; ++j) wt[j] = *(const GAS pg8::f32x2*)(cw + j * CCH + 2 * cp);
        const pg8::f32x2 bias = *(const GAS pg8::f32x2*)(cb + 2 * cp);
#pragma unroll 1
        for (int ob = 0; ob < CV_T / 4; ++ob) {
            pg8::f32x2 a[4] = {bias, bias, bias, bias};
            LAS const unsigned char* sp = st + (4 * ob) * 1536 + 4 * cp;
#pragma unroll
            for (int rr = 0; rr < 34; ++rr) {
                const unsigned pk = *(const LAS unsigned*)(sp + rr * 1536);
                pg8::f32x2 x; x.x = __uint_as_float(pk << 16); x.y = __uint_as_float(pk & 0xffff0000u);
#pragma unroll
                for (int k = 0; k < 4; ++k) { const int j = rr - k; if (j >= 0 && j < CONVK) a[k] += wt[j < 0 ? 0 : (j >= CONVK ? 0 : j)] * x; }
            }
#pragma unroll
            for (int k = 0; k < 4; ++k) *(LAS pg8::f32x2*)(st + CV_OUT_OFF + ((4 * ob + k) * CCH + 2 * cp) * 4) = a[k];
        }
    }
    __syncthreads();
#pragma unroll 1
    for (int o = F.wave; o < CV_T; o += NWAVES) {
        f32x4 v[3]; float s = 0.f;
#pragma unroll
        for (int k = 0; k < 3; ++k) { v[k] = *(const LAS f32x4*)(st + CV_OUT_OFF + (o * CCH + 4 * F.lane + 256 * k) * 4); s += (v[k].x + v[k].y) + (v[k].z + v[k].w); }
        const float mean = wave_sum(s) * (1.0f / CCH); float s2 = 0.f;
#pragma unroll
        for (int k = 0; k < 3; ++k) { v[k] = v[k] - mean; s2 += (v[k].x * v[k].x + v[k].y * v[k].y) + (v[k].z * v[k].z + v[k].w * v[k].w); }
        const float rstd = 1.0f / sqrtf(wave_sum(s2) * (1.0f / CCH) + EPS);
        bf16* orow = C2 + ((size_t)b * SEQ + t0 + o) * CCH;
#pragma unroll
        for (int k = 0; k < 3; ++k) { const int ch = 4 * F.lane + 256 * k; const f32x4 gg = *(const GAS f32x4*)(lg + ch), bb = *(const GAS f32x4*)(lb + ch);
            f32x4 y = v[k] * rstd * gg + bb;
#pragma unroll
            for (int j = 0; j < 4; ++j) y[j] = y[j] * pg8::sigmoidf_fast(y[j]);
            pg8::u32x2 wv; wv.x = cvtpk(y[0], y[1]); wv.y = cvtpk(y[2], y[3]); *(GAS pg8::u32x2*)(orow + ch) = wv; }
    }
    __syncthreads();
}

__device__ __forceinline__ void merge_item(Frame& F, int item, const bf16* OG, const float* LSE, bf16* ATT) {
    const size_t tok0 = (size_t)item * 64 + F.wave * 8; const int hh = F.lane >> 4;
#pragma unroll
    for (int half = 0; half < 2; ++half) {
        float l[4][3]; v4u d[4][3];
#pragma unroll
        for (int i = 0; i < 4; ++i)
#pragma unroll
            for (int g = 0; g < 3; ++g) { const size_t tok = tok0 + half * 4 + i;
                l[i][g] = LSE[((size_t)g * M + tok) * 4 + hh]; d[i][g] = *(const GAS v4u*)(OG + ((size_t)g * M + tok) * AOUT + 8 * F.lane); }
#pragma unroll
        for (int i = 0; i < 4; ++i) { const size_t tok = tok0 + half * 4 + i;
            const float mx = fmaxf(l[i][0], fmaxf(l[i][1], l[i][2]));
            float w0 = __builtin_amdgcn_exp2f(l[i][0] - mx), w1 = __builtin_amdgcn_exp2f(l[i][1] - mx), w2 = __builtin_amdgcn_exp2f(l[i][2] - mx);
            const float inv = 1.0f / (w0 + w1 + w2); w0 *= inv; w1 *= inv; w2 *= inv;
            v4u o;
#pragma unroll
            for (int k = 0; k < 4; ++k) {
                const float lo = w0 * __uint_as_float(d[i][0][k] << 16) + w1 * __uint_as_float(d[i][1][k] << 16) + w2 * __uint_as_float(d[i][2][k] << 16);
                const float hi = w0 * __uint_as_float(d[i][0][k] & 0xffff0000u) + w1 * __uint_as_float(d[i][1][k] & 0xffff0000u) + w2 * __uint_as_float(d[i][2][k] & 0xffff0000u);
                o[k] = cvtpk(lo, hi); }
            *(GAS v4u*)(ATT + tok * AOUT + 8 * F.lane) = o; }
    }
}

__device__ __forceinline__ void cross_attn_unit(Frame& F, int unit, const bf16* CQ, const bf16* CKV, bf16* CO) {
    const int qb = unit & 31, hd = (unit >> 5) & 3, b = unit >> 7;
    int tid = F.tid; asm volatile("" : "+v"(tid));
    const int lane = tid & 63, w = F.wave, ql = lane & 31, hi = lane >> 5;
    LAS unsigned char* img = F.lds + RING_OFF;
    const bf16* KVb = CKV + (size_t)b * NMEM * 2048 + hd * 256;
    const unsigned goff = (unsigned)((tid >> 5) * 2048 + (tid & 31) * 8);
    const unsigned loff = (unsigned)(((tid & 31) >> 4) * 65536) + offb((unsigned)(tid >> 5), (unsigned)(tid & 15));
    { v4u kk[16];
#pragma unroll
      for (int k = 0; k < 16; ++k) kk[k] = *(const GAS v4u*)(KVb + (goff + (unsigned)k * 32768u));
#pragma unroll
      for (int k = 0; k < 16; ++k) *(LAS v4u*)(img + loff + k * 4096) = kk[k]; }
    const size_t qrowi = (size_t)b * SEQ + qb * 256 + 32 * w + ql;
    const bf16* qrow = CQ + qrowi * D + hd * 256 + 8 * hi;
    unsigned ka[8], va[4][2];
#pragma unroll
    for (int ks = 0; ks < 8; ++ks) ka[ks] = offb(ql, 2 * ks + hi);
#pragma unroll
    for (int c = 0; c < 4; ++c) { va[c][0] = tr_addr(lane, 0, c, 0); va[c][1] = tr_addr(lane, 0, c, 1); }
    __syncthreads();
    f32x16 s[8];
#pragma unroll
    for (int t = 0; t < 8; ++t)
#pragma unroll
        for (int i = 0; i < 16; ++i) s[t][i] = 0.f;
#pragma unroll
    for (int dh = 0; dh < 2; ++dh) {
        bf16x8 qf[8];
#pragma unroll
        for (int ks = 0; ks < 8; ++ks) qf[ks] = *(const GAS bf16x8*)(qrow + 128 * dh + 16 * ks);
#pragma unroll
        for (int t = 0; t < 8; ++t) {
            __builtin_amdgcn_sched_barrier(0);
            bf16x8 kf[8];
#pragma unroll
            for (int ks = 0; ks < 8; ++ks) kf[ks] = *(const LAS bf16x8*)(img + dh * 65536 + ka[ks] + t * 8192);
#pragma unroll
            for (int ks = 0; ks < 8; ++ks) s[t] = __builtin_amdgcn_mfma_f32_32x32x16_bf16(kf[ks], qf[ks], s[t], 0, 0, 0);
        }
    }
    float mx = s[0][0];
#pragma unroll
    for (int t = 0; t < 8; ++t)
#pragma unroll
        for (int i = 0; i < 16; ++i) mx = fmaxf(mx, s[t][i]);
    mx = fmaxf(mx, __shfl_xor(mx, 32));
    float l = 0.f; bf16x8 pf[8][2];
#pragma unroll
    for (int t = 0; t < 8; ++t) {
#pragma unroll
        for (int i = 0; i < 16; ++i) { s[t][i] = __builtin_amdgcn_exp2f(s[t][i] - mx); l += s[t][i]; }
#pragma unroll
        for (int ks = 0; ks < 2; ++ks) { v4u pw; pw.x = cvtpk(s[t][8 * ks + 0], s[t][8 * ks + 1]); pw.y = cvtpk(s[t][8 * ks + 2], s[t][8 * ks + 3]); pw.z = cvtpk(s[t][8 * ks + 4], s[t][8 * ks + 5]); pw.w = cvtpk(s[t][8 * ks + 6], s[t][8 * ks + 7]);
            pf[t][ks] = __builtin_bit_cast(bf16x8, pw); }
    }
    l += __shfl_xor(l, 32);
    __builtin_amdgcn_sched_barrier(0);
    { v4u vv[16];
#pragma unroll
      for (int k = 0; k < 16; ++k) vv[k] = *(const GAS v4u*)(KVb + (1024u + goff + (unsigned)k * 32768u));
      __syncthreads();
#pragma unroll
      for (int k = 0; k < 16; ++k) *(LAS v4u*)(img + loff + k * 4096) = vv[k]; }
    __syncthreads();
    f32x16 oT[8];
#pragma unroll
    for (int c = 0; c < 8; ++c)
#pragma unroll
        for (int i = 0; i < 16; ++i) oT[c][i] = 0.f;
#pragma unroll
    for (int t = 0; t < 8; ++t)
#pragma unroll
        for (int c = 0; c < 8; ++c)
#pragma unroll
            for (int ks = 0; ks < 2; ++ks) {
                if (ks == 0 && (c & 1) == 0) __builtin_amdgcn_sched_barrier(0);
                LAS const unsigned char* im = img + (c >> 2) * 65536 + (32 * t + 16 * ks) * 256;
                const s16x4 lo = vtr(im + va[c & 3][0]), hh = vtr(im + va[c & 3][1]);
                const bf16x8 vf = (bf16x8){lo[0], lo[1], lo[2], lo[3], hh[0], hh[1], hh[2], hh[3]};
                oT[c] = __builtin_amdgcn_mfma_f32_32x32x16_bf16(vf, pf[t][ks], oT[c], 0, 0, 0);
            }
    const float inv = 1.0f / l;
    bf16* op = CO + qrowi * D + hd * 256 + 4 * hi;
#pragma unroll
    for (int c = 0; c < 8; ++c)
#pragma unroll
        for (int i4 = 0; i4 < 4; ++i4) { pg8::u32x2 wv; wv.x = cvtpk(oT[c][4 * i4] * inv, oT[c][4 * i4 + 1] * inv); wv.y = cvtpk(oT[c][4 * i4 + 2] * inv, oT[c][4 * i4 + 3] * inv);
            *(GAS pg8::u32x2*)(op + 32 * c + 8 * i4) = wv; }
    __syncthreads();
}

struct Args { const float* in[21]; float* out; unsigned char* ws; int ph_lo, ph_hi; };
typedef const __attribute__((address_space(4))) Args* ArgP;
__device__ __forceinline__ ArgP argp() { ArgP p = (ArgP)__builtin_amdgcn_kernarg_segment_ptr(); asm volatile("" : "+s"(p)); return p; }
#define WSP(T, off) ((T*)(A->ws + (off)))

__device__ __forceinline__ void ph0(Frame& F) {
    ArgP A = argp();
    const int gw = F.vcu * NWAVES + F.wave, NGW = F.G * NWAVES;
    LAS float* scr = (LAS float*)(F.lds + RING_OFF + F.wave * 16384);
    constexpr int I_IN = (D / 64) * (NIN / 32), I_AP = (AOUT / 64) * (D / 32), I_CP = (CCH / 64) * (D / 32), I_SQ = (D / 64) * (D / 32), I_CKV = (D / 64) * (2 * D / 32), I_UP = (D / 64) * (FF / 32), I_DN = (FF / 64) * (D / 32);
    constexpr int NITEMS = I_IN + I_AP + I_CP + 3 * I_SQ + I_CKV + I_UP + I_DN;
#pragma unroll 1
    for (int it = gw; it < NITEMS; it += NGW) {
        int r = it;
        if (r < I_IN) { p0_transpose_item<1>(A->in[3], D, NIN, WSP(bf16, WS_WIN), nullptr, scr, r, F.lane); continue; } r -= I_IN;
        if (r < I_AP) { p0_transpose_item<0>(A->in[9], AOUT, D, WSP(bf16, WS_WAP), nullptr, scr, r, F.lane); continue; } r -= I_AP;
        if (r < I_CP) { p0_transpose_item<0>(A->in[10], CCH, D, WSP(bf16, WS_WCP), nullptr, scr, r, F.lane); continue; } r -= I_CP;
        if (r < I_SQ) { p0_transpose_item<0>(A->in[11], D, D, WSP(bf16, WS_WOUT), nullptr, scr, r, F.lane); continue; } r -= I_SQ;
        if (r < I_SQ) { p0_transpose_item<0>(A->in[14], D, D, WSP(bf16, WS_WCQ), A->in[12], scr, r, F.lane); continue; } r -= I_SQ;
        if (r < I_SQ) { p0_transpose_item<0>(A->in[16], D, D, WSP(bf16, WS_WCO), nullptr, scr, r, F.lane); continue; } r -= I_SQ;
        if (r < I_CKV) { p0_transpose_item<0>(A->in[15], D, 2 * D, WSP(bf16, WS_WCKV), nullptr, scr, r, F.lane); continue; } r -= I_CKV;
        if (r < I_UP) { p0_transpose_item<0>(A->in[18], D, FF, WSP(bf16, WS_WUP), A->in[17], scr, r, F.lane); continue; } r -= I_UP;
        p0_transpose_item<0>(A->in[19], FF, D, WSP(bf16, WS_WDN), nullptr, scr, r, F.lane);
    }
#pragma unroll 1
    for (int m = gw; m < M; m += NGW) rms_row_to_bf16(F.lane, A->in[0] + (size_t)m * D, A->in[2], WSP(bf16, WS_XN) + (size_t)m * D);
#pragma unroll 1
    for (int m = gw; m < MROWS; m += NGW) rms_row_to_bf16(F.lane, A->in[1] + (size_t)m * D, A->in[13], WSP(bf16, WS_MN) + (size_t)m * D);
#pragma unroll 1
    for (int i = F.vcu * (NWAVES * 64) + F.tid; i < SEQ * 16; i += F.G * NWAVES * 64) rope_entry(i, WSP(float, WS_ROPE));
}
__device__ __forceinline__ void ph1(Frame& F) {
    ArgP A = argp();
    pg8::Gemm g{WSP(bf16, WS_XN), WSP(bf16, WS_WIN), M, NIN, D}; pg8::StaticOrder S; S.init(M, NIN, F.G, (int)blockIdx.x);
    pg8::EpiG1 E{WSP(bf16, WS_Z), WSP(bf16, WS_C), (bf16*)A->out, WSP(float, WS_ROPE), A->in[4], QSCALE};
    pg8::gemm_phase<pg8::EpiG1, pg8::StaticOrder, true, true>(F.lds + RING_OFF, g, S, E);
}
__device__ __forceinline__ void ph2(Frame& F) {
    ArgP A = argp();
    dil_attn_phase(F, WSP(bf16, WS_Z), WSP(bf16, WS_OG), WSP(float, WS_LSE));
}
__device__ __forceinline__ void ph3(Frame& F) {
    ArgP A = argp();
    const int NG = F.G >= 32 ? 16 : 0;
    if ((int)blockIdx.x < NG || NG == 0) {
        pg8::Gemm g{WSP(bf16, WS_MN), WSP(bf16, WS_WCKV), MROWS, 2 * D, D}; pg8::StaticOrder S; S.init(MROWS, 2 * D, NG ? NG : F.G, (int)blockIdx.x);
        pg8::EpiPlainBf16 E{WSP(bf16, WS_CKV), 2 * D};
        pg8::gemm_phase<pg8::EpiPlainBf16, pg8::StaticOrder, true, true>(F.lds + RING_OFF, g, S, E);
    }
    if ((int)blockIdx.x >= NG) {
        const int wi = (int)blockIdx.x - NG, nw = F.G - NG;
#pragma unroll 1
        for (int u = wi; u < M / CV_T; u += nw) conv_unit(F, u, WSP(bf16, WS_C), A->in[5], A->in[6], A->in[7], A->in[8], WSP(bf16, WS_C2));
#pragma unroll 1
        for (int u = wi; u < 256; u += nw) merge_item(F, u, WSP(bf16, WS_OG), WSP(float, WS_LSE), WSP(bf16, WS_ATTN));
    }
}
__device__ __forceinline__ void ph4(Frame& F) {
    { ArgP A = argp();
      pg8::Gemm g{WSP(bf16, WS_ATTN), WSP(bf16, WS_WAP), M, D, AOUT}; pg8::StaticOrder S; S.init(M, D, F.G, (int)blockIdx.x);
      pg8::EpiGate<0> E{(const bf16*)A->out, 0, WSP(float, WS_TMP), WSP(bf16, WS_MERGED)};
      pg8::gemm_phase<pg8::EpiGate<0>, pg8::StaticOrder, true, true>(F.lds + RING_OFF, g, S, E); }
    { ArgP A = argp();
      pg8::Gemm g{WSP(bf16, WS_C2), WSP(bf16, WS_WCP), M, D, CCH}; pg8::StaticOrder S; S.init(M, D, F.G, (int)blockIdx.x);
      pg8::EpiGate<1> E{(const bf16*)A->out, 1024, WSP(float, WS_TMP), WSP(bf16, WS_MERGED)};
      pg8::gemm_phase<pg8::EpiGate<1>, pg8::StaticOrder, true, true>(F.lds + RING_OFF, g, S, E); }
}
__device__ __forceinline__ void ph5(Frame& F) {
    ArgP A = argp();
    pg8::Gemm g{WSP(bf16, WS_MERGED), WSP(bf16, WS_WOUT), M, D, D}; pg8::StaticOrder S; S.init(M, D, F.G, (int)blockIdx.x);
    pg8::EpiRes E{A->in[0], A->out, WSP(bf16, WS_X1B), WSP(float, WS_SSQ1)};
    pg8::gemm_phase<pg8::EpiRes, pg8::StaticOrder, true, true>(F.lds + RING_OFF, g, S, E);
}
__device__ __forceinline__ void ph6(Frame& F) {
    ArgP A = argp();
    pg8::Gemm g{WSP(bf16, WS_X1B), WSP(bf16, WS_WCQ), M, D, D}; pg8::StaticOrder S; S.init(M, D, F.G, (int)blockIdx.x);
    pg8::EpiRmsBf16<0> E{WSP(bf16, WS_CQ), D, WSP(float, WS_SSQ1), CQSCALE, EPS};
    pg8::gemm_phase<pg8::EpiRmsBf16<0>, pg8::StaticOrder, true, true>(F.lds + RING_OFF, g, S, E);
}
__device__ __forceinline__ void ph7(Frame& F) {
    ArgP A = argp();
#pragma unroll 1
    for (int u = F.vcu; u < 256; u += F.G) cross_attn_unit(F, u, WSP(bf16, WS_CQ), WSP(bf16, WS_CKV), WSP(bf16, WS_CO));
}
__device__ __forceinline__ void ph8(Frame& F) {
    ArgP A = argp();
    pg8::Gemm g{WSP(bf16, WS_CO), WSP(bf16, WS_WCO), M, D, D}; pg8::StaticOrder S; S.init(M, D, F.G, (int)blockIdx.x);
    pg8::EpiRes E{A->out, A->out, WSP(bf16, WS_X2B), WSP(float, WS_SSQ2)};
    pg8::gemm_phase<pg8::EpiRes, pg8::StaticOrder, true, true>(F.lds + RING_OFF, g, S, E);
}
__device__ __forceinline__ void ph9(Frame& F) {
    ArgP A = argp();
    pg8::Gemm g{WSP(bf16, WS_X2B), WSP(bf16, WS_WUP), M, FF, D}; pg8::StaticOrder S; S.init(M, FF, F.G, (int)blockIdx.x);
    pg8::EpiRmsBf16<1> E{WSP(bf16, WS_H), FF, WSP(float, WS_SSQ2), 1.0f, EPS};
    pg8::gemm_phase<pg8::EpiRmsBf16<1>, pg8::StaticOrder, true, true>(F.lds + RING_OFF, g, S, E);
}
__device__ __forceinline__ void ph10(Frame& F) {
    ArgP A = argp();
    pg8::Gemm g{WSP(bf16, WS_H), WSP(bf16, WS_WDN), M, D, FF}; pg8::StaticOrder S; S.init(M, D, F.G, (int)blockIdx.x);
    pg8::EpiRes E{A->out, A->out, nullptr, WSP(float, WS_SSQ3)};
    pg8::gemm_phase<pg8::EpiRes, pg8::StaticOrder, true, true>(F.lds + RING_OFF, g, S, E);
}
__device__ __forceinline__ void ph11(Frame& F) {
    ArgP A = argp();
    const int gw = F.vcu * NWAVES + F.wave, NGW = F.G * NWAVES;
    float* out = A->out; const float* SSQ3 = WSP(float, WS_SSQ3); const float* g_final = A->in[20];
#pragma unroll 1
    for (int m = gw; m < M; m += NGW) {
        const f32x4* sp = (const f32x4*)(SSQ3 + (size_t)m * 16); const f32x4 st = (sp[0] + sp[1]) + (sp[2] + sp[3]);
        const float rstd = 1.0f / sqrtf(((st[0] + st[1]) + (st[2] + st[3])) * (1.0f / D) + EPS);
        GAS f32x4* xr = (GAS f32x4*)(out + (size_t)m * D) + F.lane; const GAS f32x4* gr = (const GAS f32x4*)g_final + F.lane;
#pragma unroll
        for (int j = 0; j < 4; ++j) { const f32x4 v = xr[64 * j]; xr[64 * j] = v * rstd * gr[64 * j]; }
    }
}

#ifndef PH_MASK
#define PH_MASK 0xFFF
#endif
__global__ void __launch_bounds__(NWAVES * 64, 2) mk_fwd(Args args) {
    extern __shared__ __attribute__((aligned(16))) unsigned char lds[];
    Frame F;
    F.lds = (LAS unsigned char*)lds;
    F.MISC = (volatile LAS unsigned*)(F.lds + MISC_OFF);
    F.tid = threadIdx.x; F.lane = F.tid & 63; F.wave = __builtin_amdgcn_readfirstlane(F.tid >> 6);
    F.G = gridDim.x; { const int bx = blockIdx.x; F.vcu = (F.G % 8 == 0) ? (bx % 8) * (F.G / 8) + bx / 8 : bx; }
    F.ctl = (gu32*)(args.ws + WS_CTL);
    for (int u = F.tid; u < (LDS_BYTES - LDSCTL_OFF) / 4; u += NWAVES * 64) ((LAS unsigned*)(F.lds + LDSCTL_OFF))[u] = 0u;
    __syncthreads();
    const int lo = args.ph_lo, hi = args.ph_hi;
    const bool multi = (hi - lo) > 1;
    XcdBarrier bar; bar.bar = (unsigned*)(F.ctl + CW_BAR); bar.x = 0; bar.st = nullptr;
    if (multi) bar = xcd_barrier_post((unsigned*)(F.ctl + CW_BAR), F.MISC + 8);
#define IN(k) (((PH_MASK >> (k)) & 1) && lo <= (k) && (k) < hi)
#define SEAM(k) do { if (lo <= (k) && (k) + 1 < hi) xcd_barrier(bar); } while (0)
#ifndef REP_MASK
#define REP_MASK 0
#endif
#define RUNPH(k, fn) do { if (IN(k)) { fn(F); if ((REP_MASK >> (k)) & 1) { xcd_barrier(bar); fn(F); } } } while (0)
    RUNPH(0, ph0);
    SEAM(0);
    RUNPH(1, ph1);
    SEAM(1);
    RUNPH(2, ph2);
    SEAM(2);
    RUNPH(3, ph3);
    SEAM(3);
    RUNPH(4, ph4);
    SEAM(4);
    RUNPH(5, ph5);
    SEAM(5);
    RUNPH(6, ph6);
    SEAM(6);
    RUNPH(7, ph7);
    SEAM(7);
    RUNPH(8, ph8);
    SEAM(8);
    RUNPH(9, ph9);
    SEAM(9);
    RUNPH(10, ph10);
    SEAM(10);
    RUNPH(11, ph11);
#undef IN
#undef SEAM
}

#ifndef MK_ONE_LAUNCH
#define MK_ONE_LAUNCH 1
#endif
constexpr int N_PHASES = 12;
extern "C" void kernel_launch(void* const* d_in, const int* in_sizes, int n_in, void* d_out, int out_size, void* d_ws, size_t ws_size, hipStream_t stream) {
    static int grid = 0;
    if (grid == 0) {
        if (n_in != 21 || out_size != M * D || ws_size < WS_END) { fprintf(stderr, "kernel_launch: unexpected shapes: n_in %d out %d ws %zu\n", n_in, out_size, ws_size); grid = -1; return; }
        int dev = 0, cus = 0, per_cu = 0;
        if (hipGetDevice(&dev) != hipSuccess || hipDeviceGetAttribute(&cus, hipDeviceAttributeMultiprocessorCount, dev) != hipSuccess) { grid = -1; return; }
        if (hipFuncSetAttribute((const void*)mk_fwd, hipFuncAttributeMaxDynamicSharedMemorySize, LDS_BYTES) != hipSuccess) { fprintf(stderr, "kernel_launch: hipFuncSetAttribute failed\n"); grid = -1; return; }
        if (hipOccupancyMaxActiveBlocksPerMultiprocessor(&per_cu, (const void*)mk_fwd, NWAVES * 64, LDS_BYTES) != hipSuccess || per_cu < 1) { fprintf(stderr, "kernel_launch: occupancy query says %d blocks per CU\n", per_cu); (void)hipGetLastError(); grid = -1; return; }
        grid = cus;
    }
    if (grid < 0) return;
    (void)hipMemsetAsync((char*)d_ws + WS_CTL, 0, CTL_ZERO_BYTES, stream);
    Args a{};
    for (int i = 0; i < 21; ++i) a.in[i] = (const float*)d_in[i];
    a.out = (float*)d_out; a.ws = (unsigned char*)d_ws;
#if MK_ONE_LAUNCH
    a.ph_lo = 0; a.ph_hi = N_PHASES;
    void* kargs[] = {&a};
    hipError_t e = hipLaunchCooperativeKernel((const void*)mk_fwd, dim3(grid), dim3(NWAVES * 64), kargs, LDS_BYTES, stream);
    if (e != hipSuccess) fprintf(stderr, "kernel_launch: cooperative launch failed: %s (grid %d)\n", hipGetErrorString(e), grid);
#else
    for (int p = 0; p < N_PHASES; ++p) { a.ph_lo = p; a.ph_hi = p + 1; hipLaunchKernelGGL(mk_fwd, dim3(grid), dim3(NWAVES * 64), LDS_BYTES, stream, a); }
#endif
}
```
